# Optimizing an MI355X kernel written in HIP

```python
import math
import jax, jax.numpy as jnp
from jax import lax
import numpy as np

D_MODEL = 1024
BATCH = 2
SEQ = 16384
DEPTH = 2

GRID_W = 64
RET_HEADS = 4
RET_DK = 128
RET_DV = 128
RET_CHUNK = 128
NA_HEADS = 8
NA_DH = 64
NA_KH = 8
NA_KW = 16
GQA_HEADS = 8
GQA_KV_HEADS = 2
GQA_DH = 64
Q_BLOCK = 128
ROPE_THETA = 10000.0
RMS_EPS = 1e-6
LN_EPS = 1e-5

RET_W = RET_HEADS * RET_DV
NA_W = NA_HEADS * NA_DH
GQA_W = GQA_HEADS * GQA_DH
GQA_KV_W = GQA_KV_HEADS * GQA_DH

IN_SEGMENTS = (
    ("ret_q", RET_HEADS * RET_DK, False),
    ("ret_k", RET_HEADS * RET_DK, False),
    ("ret_v", RET_W, True),
    ("ret_z", RET_W, False),
    ("na_q", NA_W, False),
    ("na_k", NA_W, False),
    ("na_v", NA_W, True),
    ("na_z", NA_W, False),
    ("gqa_q", GQA_W, False),
    ("gqa_k", GQA_KV_W, False),
    ("gqa_v", GQA_KV_W, True),
    ("gqa_z", GQA_W, False),
    ("gate_a", D_MODEL, False),
    ("gate_b", D_MODEL, False),
    ("gate_c", D_MODEL, False),
)
D_IN = sum(s for _, s, _ in IN_SEGMENTS)

kernel_name = "hybrid_retention_natten_gqa_encoder"


def _dense(key, shape, fan_in, scale=1.0):
    return jax.random.normal(key, shape, jnp.float32) * (scale * fan_in ** -0.5)


def _split_columns(p):
    idx = []
    acc = 0
    for _, size, _ in IN_SEGMENTS[:-1]:
        acc += size
        idx.append(acc)
    return jnp.split(p, idx, axis=-1)


def _layer_norm(x, g, b):
    xf = x.astype(jnp.float32)
    mu = jnp.mean(xf, -1, keepdims=True)
    var = jnp.mean(jnp.square(xf - mu), -1, keepdims=True)
    return ((xf - mu) * lax.rsqrt(var + LN_EPS) * g.astype(jnp.float32) + b.astype(jnp.float32)).astype(x.dtype)


def _rms_norm(x, g):
    xf = x.astype(jnp.float32)
    return (xf * lax.rsqrt(jnp.mean(jnp.square(xf), -1, keepdims=True) + RMS_EPS) * g.astype(jnp.float32)).astype(x.dtype)


def _apply_rope(x, cos, sin):
    half = x.shape[-1] // 2
    x1 = x[..., :half].astype(jnp.float32)
    x2 = x[..., half:].astype(jnp.float32)
    return jnp.concatenate([x1 * cos - x2 * sin, x2 * cos + x1 * sin], -1).astype(x.dtype)


def _retention_bidir(q, k, v, theta_f, theta_b):
    B_, L, H, dk = q.shape
    dv = v.shape[-1]
    C = RET_CHUNK
    N = L // C
    dt = q.dtype
    lf = jax.nn.log_sigmoid(theta_f.astype(jnp.float32))
    lb = jax.nn.log_sigmoid(theta_b.astype(jnp.float32))
    pos = jnp.arange(C, dtype=jnp.float32)
    diff = pos[:, None] - pos[None, :]
    d_intra = jnp.where(diff >= 0,
                        jnp.exp(jnp.maximum(diff, 0.0) * lf[:, None, None]),
                        jnp.exp(jnp.maximum(-diff, 0.0) * lb[:, None, None]))
    w_kf = jnp.exp((C - 1 - pos)[None, :] * lf[:, None])
    w_qf = jnp.exp((pos + 1.0)[None, :] * lf[:, None])
    w_kb = jnp.exp(pos[None, :] * lb[:, None])
    w_qb = jnp.exp((C - pos)[None, :] * lb[:, None])
    chunk_f = jnp.exp(C * lf)[None, :, None, None]
    chunk_b = jnp.exp(C * lb)[None, :, None, None]

    qc = (q * (dk ** -0.5)).reshape(B_, N, C, H, dk)
    kc = k.reshape(B_, N, C, H, dk)
    vc = v.reshape(B_, N, C, H, dv)
    s = jnp.einsum('bnihd,bnjhd->bnhij', qc, kc) * d_intra.astype(dt)
    o = jnp.einsum('bnhij,bnjhe->bnihe', s, vc).astype(jnp.float32)
    kv_f = jnp.einsum('bnjhd,hj,bnjhe->nbhde', kc, w_kf.astype(dt), vc).astype(jnp.float32)
    kv_b = jnp.einsum('bnjhd,hj,bnjhe->nbhde', kc, w_kb.astype(dt), vc).astype(jnp.float32)

    def step_f(S, kv):
        return chunk_f * S + kv, S

    def step_b(R, kv):
        return chunk_b * R + kv, R

    zeros = jnp.zeros((B_, H, dk, dv), jnp.float32)
    _, states_f = lax.scan(step_f, zeros, kv_f)
    _, states_b = lax.scan(step_b, zeros, kv_b, reverse=True)
    qf = qc.astype(jnp.float32)
    o = o + jnp.einsum('bnihd,hi,nbhde->bnihe', qf, w_qf, states_f)
    o = o + jnp.einsum('bnihd,hi,nbhde->bnihe', qf, w_qb, states_b)
    return o.reshape(B_, L, H, dv).astype(dt)


def _neighbourhood_attention(q, k, v, rpb):
    B_, L, H, d = q.shape
    rows = L // GRID_W
    kh = min(NA_KH, rows)
    rows_per_block = Q_BLOCK // GRID_W
    n_blocks = rows // rows_per_block
    qg = (q * (d ** -0.5)).reshape(B_, rows, GRID_W, H, d)
    kg = k.reshape(B_, rows, GRID_W, H, d)
    vg = v.reshape(B_, rows, GRID_W, H, d)
    col = jnp.arange(GRID_W)
    col_start = jnp.clip(col - NA_KW // 2, 0, GRID_W - NA_KW)
    col_in = (col[None, :] >= col_start[:, None]) & (col[None, :] < col_start[:, None] + NA_KW)
    col_idx = jnp.clip(col[None, :] - col[:, None] + NA_KW - 1, 0, 2 * NA_KW - 2)
    mask = col_in[:, None, :]
    neg = jnp.finfo(jnp.float32).min

    def block(i):
        r = i * rows_per_block + jnp.arange(rows_per_block)
        r_start = jnp.clip(r - kh // 2, 0, rows - kh)
        key_rows = r_start[:, None] + jnp.arange(kh)[None, :]
        qb = lax.dynamic_slice_in_dim(qg, i * rows_per_block, rows_per_block, axis=1)
        kb = kg[:, key_rows]
        vb = vg[:, key_rows]
        row_idx = key_rows - r[:, None] + NA_KH - 1
        bias = rpb[:, row_idx][..., col_idx]
        bias = jnp.transpose(bias, (0, 1, 3, 2, 4)).astype(jnp.float32)
        s = jnp.einsum('brqhd,brkwhd->bhrqkw', qb, kb).astype(jnp.float32) + bias[None]
        s = jnp.where(mask, s, neg)
        sh = s.shape
        p = jax.nn.softmax(s.reshape(sh[:-2] + (sh[-2] * sh[-1],)), axis=-1).reshape(sh).astype(v.dtype)
        return jnp.einsum('bhrqkw,brkwhd->brqhd', p, vb)

    o = lax.map(block, jnp.arange(n_blocks))
    return jnp.moveaxis(o, 0, 1).reshape(B_, L, H * d)


def _gqa_attention(q, k, v):
    B_, L, Hq, d = q.shape
    Hkv = k.shape[2]
    G = Hq // Hkv
    qb = (q * (d ** -0.5)).reshape(B_, L // Q_BLOCK, Q_BLOCK, Hkv, G, d)
    qb = jnp.moveaxis(qb, 1, 0)

    def block(qi):
        s = jnp.einsum('bqngd,bknd->bngqk', qi, k).astype(jnp.float32)
        p = jax.nn.softmax(s, axis=-1).astype(v.dtype)
        return jnp.einsum('bngqk,bknd->bqngd', p, v)

    o = lax.map(block, qb)
    return jnp.moveaxis(o, 0, 1).reshape(B_, L, Hq * d)


def _hybrid_layer(x, w_in, theta_f, theta_b, gn_gain, rpb, q_norm, k_norm,
                  w_a, w_b, w_c, w_out, ln_g, ln_b, ret_cs, ax_cs, alpha):
    B_, L, _ = x.shape
    p = jnp.einsum('bld,de->ble', x, w_in)
    (rq, rk, rv, rz, nq, nk, nv, nz, cq, ck, cv, cz, ga, gb, gc) = _split_columns(p)

    rq = _apply_rope(rq.reshape(B_, L, RET_HEADS, RET_DK), *ret_cs)
    rk = _apply_rope(rk.reshape(B_, L, RET_HEADS, RET_DK), *ret_cs)
    ra = _retention_bidir(rq, rk, rv.reshape(B_, L, RET_HEADS, RET_DV), theta_f, theta_b)
    raf = ra.astype(jnp.float32)
    mu = jnp.mean(raf, -1, keepdims=True)
    var = jnp.mean(jnp.square(raf - mu), -1, keepdims=True)
    ra = ((raf - mu) * lax.rsqrt(var + LN_EPS)).reshape(B_, L, RET_W) * gn_gain.astype(jnp.float32)
    o_a = ra.astype(x.dtype) * jax.nn.silu(rz)

    o_b = _neighbourhood_attention(nq.reshape(B_, L, NA_HEADS, NA_DH), nk.reshape(B_, L, NA_HEADS, NA_DH),
                                   nv.reshape(B_, L, NA_HEADS, NA_DH), rpb) * jax.nn.silu(nz)

    cq = _apply_rope(_rms_norm(cq.reshape(B_, L, GQA_HEADS, GQA_DH), q_norm), *ax_cs)
    ck = _apply_rope(_rms_norm(ck.reshape(B_, L, GQA_KV_HEADS, GQA_DH), k_norm), *ax_cs)
    o_c = _gqa_attention(cq, ck, cv.reshape(B_, L, GQA_KV_HEADS, GQA_DH)) * jax.nn.silu(cz)

    y = (jax.nn.sigmoid(ga) * (o_a @ w_a)
         + jax.nn.sigmoid(gb) * (o_b @ w_b)
         + jax.nn.sigmoid(gc) * (o_c @ w_c))
    out = y @ w_out
    return _layer_norm(alpha * x + out, ln_g, ln_b)


def setup_inputs(seed: int = 0) -> dict:
    key = jax.random.key(seed)
    ks = jax.random.split(key, 16)
    beta = (8.0 * DEPTH) ** -0.25
    x = jax.random.normal(ks[0], (BATCH, SEQ, D_MODEL), jnp.float32)
    seg_keys = jax.random.split(ks[1], len(IN_SEGMENTS))
    parts = [_dense(sk, (DEPTH, D_MODEL, size), D_MODEL, beta if is_v else 1.0)
             for sk, (_, size, is_v) in zip(seg_keys, IN_SEGMENTS)]
    w_in = jnp.concatenate(parts, axis=-1)
    eps = 2.0 ** (-5.0 - jnp.arange(RET_HEADS, dtype=jnp.float32))
    theta0 = jnp.log((1.0 - eps) / eps)
    ret_theta_fwd = theta0[None] + 0.1 * jax.random.normal(ks[2], (DEPTH, RET_HEADS), jnp.float32)
    ret_theta_bwd = theta0[None] + 0.1 * jax.random.normal(ks[3], (DEPTH, RET_HEADS), jnp.float32)
    ret_gn_gain = 1.0 + 0.02 * jax.random.normal(ks[4], (DEPTH, RET_W), jnp.float32)
    na_rpb = 0.02 * jax.random.normal(ks[5], (DEPTH, NA_HEADS, 2 * NA_KH - 1, 2 * NA_KW - 1), jnp.float32)
    gqa_q_norm = 1.0 + 0.02 * jax.random.normal(ks[6], (DEPTH, GQA_DH), jnp.float32)
    gqa_k_norm = 1.0 + 0.02 * jax.random.normal(ks[7], (DEPTH, GQA_DH), jnp.float32)
    w_branch_a = _dense(ks[8], (DEPTH, RET_W, D_MODEL), RET_W, beta)
    w_branch_b = _dense(ks[9], (DEPTH, NA_W, D_MODEL), NA_W, beta)
    w_branch_c = _dense(ks[10], (DEPTH, GQA_W, D_MODEL), GQA_W, beta)
    w_out = _dense(ks[11], (DEPTH, D_MODEL, D_MODEL), D_MODEL, beta)
    ln_gain = 1.0 + 0.02 * jax.random.normal(ks[12], (DEPTH, D_MODEL), jnp.float32)
    ln_bias = 0.02 * jax.random.normal(ks[13], (DEPTH, D_MODEL), jnp.float32)
    return {"x": x, "w_in": w_in, "ret_theta_fwd": ret_theta_fwd, "ret_theta_bwd": ret_theta_bwd,
            "ret_gn_gain": ret_gn_gain, "na_rpb": na_rpb, "gqa_q_norm": gqa_q_norm,
            "gqa_k_norm": gqa_k_norm, "w_branch_a": w_branch_a, "w_branch_b": w_branch_b,
            "w_branch_c": w_branch_c, "w_out": w_out, "ln_gain": ln_gain, "ln_bias": ln_bias}


def reference(x, w_in, ret_theta_fwd, ret_theta_bwd, ret_gn_gain, na_rpb, gqa_q_norm,
              gqa_k_norm, w_branch_a, w_branch_b, w_branch_c, w_out, ln_gain, ln_bias):
    L = x.shape[1]
    alpha = (2.0 * DEPTH) ** 0.25
    t = jnp.arange(L)
    tf = t.astype(jnp.float32)
    row = (t // GRID_W).astype(jnp.float32)
    col = (t % GRID_W).astype(jnp.float32)
    inv_ret = 1.0 / (ROPE_THETA ** jnp.linspace(0.0, 1.0, RET_DK // 2, dtype=jnp.float32))
    ang_ret = tf[:, None] * inv_ret[None, :]
    ret_cs = (jnp.cos(ang_ret)[:, None, :], jnp.sin(ang_ret)[:, None, :])
    n_ax = GQA_DH // 4
    inv_ax = ROPE_THETA ** (-jnp.arange(n_ax, dtype=jnp.float32) / n_ax)
    ang_ax = jnp.concatenate([row[:, None] * inv_ax[None, :], col[:, None] * inv_ax[None, :]], -1)
    ax_cs = (jnp.cos(ang_ax)[:, None, :], jnp.sin(ang_ax)[:, None, :])
    for l in range(DEPTH):
        x = _hybrid_layer(x, w_in[l], ret_theta_fwd[l], ret_theta_bwd[l], ret_gn_gain[l], na_rpb[l],
                          gqa_q_norm[l], gqa_k_norm[l], w_branch_a[l], w_branch_b[l], w_branch_c[l],
                          w_out[l], ln_gain[l], ln_bias[l], ret_cs, ax_cs, alpha)
    return x
```

```cpp
#include <hip/hip_runtime.h>
#include <hip/hip_cooperative_groups.h>
#include <cstdio>
#include <cstdint>
namespace pg8 {
#define PG8_LAS __attribute__((address_space(3)))
typedef unsigned short bf16_t;
typedef short bf16x8 __attribute__((ext_vector_type(8)));
typedef float f32x4 __attribute__((ext_vector_type(4)));
typedef unsigned u32x4 __attribute__((ext_vector_type(4)));
constexpr int BM = 256, BK = 64, HALF = 128, HTB = HALF * BK * 2  , STAGE_BYTES = 8 * HTB, NXCD = 8, WGM = 8;

__host__ __device__ __forceinline__ int lds_byte(int r, int c) { const int st = (r >> 4) * 2 + (c >> 5), rr = r & 15, cc = c & 31, ob = rr * 64 + cc * 2; return st * 1024 + (ob ^ (((ob >> 9) & 1) << 5)); }
__host__ __device__ __forceinline__ void stage_rc(int b, int& R, int& C) { const int st = b / 1024, sb = b % 1024, swz = sb ^ (((sb >> 9) & 1) << 5); R = (st >> 1) * 16 + swz / 64; C = (st & 1) * 32 + (swz % 64) / 2; }
__host__ __device__ __forceinline__ int perm32(int rho) { const int n = rho >> 4, i = rho & 15; return 8 * (i >> 2) + 4 * n + (i & 3); }

struct Unit { int pm, pn; };
struct Gemm { const bf16_t* A; const bf16_t* Bt; int M, N, K; };

struct StaticOrder {
    int nM, nN, nwg, G, c;
    __host__ __device__ void init(int M, int N, int G_, int c_) { nM = M / BM; nN = N / BM; nwg = nM * nN; G = G_; c = c_; }
    __host__ __device__ bool next(int i, Unit& u) const {
        const long L = (long)i * G + c; if (L >= nwg) return false;
        int wgid = (int)L; { const int q = nwg / NXCD, r = nwg % NXCD, xcd = wgid % NXCD, off = wgid / NXCD; wgid = (xcd < r ? xcd * (q + 1) : r * (q + 1) + (xcd - r) * q) + off; }
        const int nig = WGM * nN, gid = wgid / nig, fm = gid * WGM, gsz = (nM - fm) < WGM ? (nM - fm) : WGM;
        u.pm = fm + ((wgid % nig) % gsz); u.pn = (wgid % nig) / gsz; return true;
    }
    __device__ __forceinline__ void a_ready(const Unit&) const {}
    __device__ __forceinline__ void done(const Unit&) const {}
};

typedef float f32x2c_t __attribute__((ext_vector_type(2))); typedef __bf16 bf16x2c_t __attribute__((ext_vector_type(2)));
__device__ __forceinline__ unsigned cvt_pk_bf16(float lo, float hi) { f32x2c_t v = {lo, hi}; bf16x2c_t b = __builtin_convertvector(v, bf16x2c_t); return __builtin_bit_cast(unsigned, b); }
typedef float f32x2 __attribute__((ext_vector_type(2)));
typedef unsigned u32x2 __attribute__((ext_vector_type(2)));
constexpr int SEQL = 16384;
__device__ __forceinline__ float bf_lo(unsigned w) { return __uint_as_float(w << 16); }
__device__ __forceinline__ float bf_hi(unsigned w) { return __uint_as_float(w & 0xffff0000u); }
__device__ __forceinline__ bf16_t f2bf1(float f) { return (bf16_t)(cvt_pk_bf16(f, 0.f) & 0xffffu); }
__device__ __forceinline__ void sincos_rad(float ang, float& s, float& c) {
    double rev = (double)ang * 0.15915494309189535; rev -= __builtin_rint(rev);
    const float f = (float)rev; s = __builtin_amdgcn_sinf(f); c = __builtin_amdgcn_cosf(f);
}
typedef unsigned u32x4e __attribute__((ext_vector_type(4)));
__device__ __forceinline__ u32x4e pack8v(const float* a) { u32x4e w; w.x = cvt_pk_bf16(a[0], a[1]); w.y = cvt_pk_bf16(a[2], a[3]); w.z = cvt_pk_bf16(a[4], a[5]); w.w = cvt_pk_bf16(a[6], a[7]); return w; }
__device__ __forceinline__ void st_t4(bf16_t* t, unsigned a, unsigned b2) { t[0] = (bf16_t)(a & 0xffffu); t[(size_t)SEQL] = (bf16_t)(a >> 16); t[(size_t)2 * SEQL] = (bf16_t)(b2 & 0xffffu); t[(size_t)3 * SEQL] = (bf16_t)(b2 >> 16); }
struct EpiIn {
    static constexpr bool PERM = true, AFTER_DRAIN = false;
    bf16_t *OA, *OB, *OC, *RK, *RKT, *RVT, *NK, *NVT, *CK, *CV; const float *qn, *kn;
    __device__ __forceinline__ void operator()(const f32x4 (&acc)[2][2][4][2], const Unit& u, int wr, int wc, int fr, int fq) const {
        const int pn = u.pn;
        const int rowb = u.pm * BM + wr * 64 + fr;
        const int bt = u.pm >> 6;
        const int posb = (u.pm & 63) * BM + wr * 64 + fr;
        if (pn < 4) {
            const bool isq = pn < 2; const float sc = isq ? 0.08838834764831845f : 1.0f;
            const int head = 2 * (pn & 1) + (wc >> 1); const int i0 = 32 * (wc & 1) + 8 * fq;
            bf16_t* dst = isq ? OA : RK;
            float inv[8];
#pragma unroll
            for (int q = 0; q < 8; ++q) inv[q] = __builtin_amdgcn_exp2f(-(float)(i0 + q) * 0.2109160695166579f);
#pragma unroll
            for (int ai = 0; ai < 2; ++ai)
#pragma unroll
                for (int m = 0; m < 4; ++m) {
                    const int row = rowb + ai * HALF + m * 16; int pos = posb + ai * HALF + m * 16; asm volatile("" : "+v"(pos));
                    float o1[8], o2[8];
#pragma unroll
                    for (int n = 0; n < 2; ++n)
#pragma unroll
                        for (int j = 0; j < 4; ++j) { float s, c; sincos_rad((float)pos * inv[4 * n + j], s, c);
                            const float x1 = acc[ai][0][m][n][j], x2 = acc[ai][1][m][n][j];
                            o1[4 * n + j] = (x1 * c - x2 * s) * sc; o2[4 * n + j] = (x2 * c + x1 * s) * sc; }
                    const u32x4e w1 = pack8v(o1), w2 = pack8v(o2);
                    bf16_t* p = dst + (size_t)row * 512 + head * 128 + i0;
                    *(u32x4e*)p = w1; *(u32x4e*)(p + 64) = w2;
                    if (!isq) {
                        bf16_t* t = RKT + ((size_t)((bt * 4 + head) * 128 + i0)) * SEQL + pos;
                        st_t4(t, w1.x, w1.y); st_t4(t + (size_t)4 * SEQL, w1.z, w1.w); st_t4(t + (size_t)64 * SEQL, w2.x, w2.y); st_t4(t + (size_t)68 * SEQL, w2.z, w2.w);
                    }
                    __builtin_amdgcn_sched_barrier(0);
                }
        } else if (pn < 8) {
            bf16_t* XT = (pn < 6) ? RVT : NVT; const int cb = 256 * ((pn < 6) ? (pn - 4) : (pn - 6)) + wc * 32 + 8 * fq;
#pragma unroll
            for (int ai = 0; ai < 2; ++ai)
#pragma unroll
                for (int m = 0; m < 4; ++m) { const int pos = posb + ai * HALF + m * 16;
#pragma unroll
                    for (int bj = 0; bj < 2; ++bj)
#pragma unroll
                        for (int n = 0; n < 2; ++n) { bf16_t* t = XT + ((size_t)(bt * 512 + cb + bj * HALF + 4 * n)) * SEQL + pos; const f32x4 v = acc[ai][bj][m][n];
                            st_t4(t, cvt_pk_bf16(v[0], v[1]), cvt_pk_bf16(v[2], v[3])); } }
        } else if (pn < 12) {
            const bool isq = pn < 10; const float sc = isq ? 0.125f : 1.0f; bf16_t* dst = isq ? OB : NK;
            const int cb = 256 * (isq ? (pn - 8) : (pn - 10)) + wc * 32 + 8 * fq;
#pragma unroll
            for (int ai = 0; ai < 2; ++ai)
#pragma unroll
                for (int m = 0; m < 4; ++m) { bf16_t* rp = dst + (size_t)(rowb + ai * HALF + m * 16) * 512 + cb;
#pragma unroll
                    for (int bj = 0; bj < 2; ++bj) { const f32x4 v0 = acc[ai][bj][m][0] * sc, v1 = acc[ai][bj][m][1] * sc; u32x4e w; w.x = cvt_pk_bf16(v0[0], v0[1]); w.y = cvt_pk_bf16(v0[2], v0[3]); w.z = cvt_pk_bf16(v1[0], v1[1]); w.w = cvt_pk_bf16(v1[2], v1[3]);
                        *(u32x4e*)(rp + bj * HALF) = w; } }
        } else if (pn < 14 || wc < 2) {
            const bool isq = pn < 14; const float sc = isq ? 0.18033688011112042f : 1.0f;
            const int head = isq ? 4 * (pn - 12) + wc : wc; const int pitch = isq ? 512 : 128;
            bf16_t* dst = isq ? OC : CK; const float* g = isq ? qn : kn;
            float g1[8], g2[8], inv[8];
#pragma unroll
            for (int q = 0; q < 8; ++q) { inv[q] = __builtin_amdgcn_exp2f(-(float)(8 * (fq & 1) + q) * 0.8304820237218406f); g1[q] = g[8 * fq + q]; g2[q] = g[32 + 8 * fq + q]; }
#pragma unroll
            for (int ai = 0; ai < 2; ++ai)
#pragma unroll
                for (int m = 0; m < 4; ++m) {
                    const int row = rowb + ai * HALF + m * 16; int pos = posb + ai * HALF + m * 16; asm volatile("" : "+v"(pos));
                    float ss = 0.f;
#pragma unroll
                    for (int bj = 0; bj < 2; ++bj)
#pragma unroll
                        for (int n = 0; n < 2; ++n) { const f32x4 v = acc[ai][bj][m][n]; ss += (v[0] * v[0] + v[1] * v[1]) + (v[2] * v[2] + v[3] * v[3]); }
                    ss += __shfl_xor(ss, 16); ss += __shfl_xor(ss, 32);
                    const float rms = 1.0f / sqrtf(ss * (1.0f / 64.0f) + 1e-6f);
                    const float pa = (fq < 2) ? (float)(pos >> 6) : (float)(pos & 63);
                    float o1[8], o2[8];
#pragma unroll
                    for (int n = 0; n < 2; ++n)
#pragma unroll
                        for (int j = 0; j < 4; ++j) { const int q = 4 * n + j; float s, c; sincos_rad(pa * inv[q], s, c);
                            const float x1 = acc[ai][0][m][n][j] * rms * g1[q], x2 = acc[ai][1][m][n][j] * rms * g2[q];
                            o1[q] = (x1 * c - x2 * s) * sc; o2[q] = (x2 * c + x1 * s) * sc; }
                    bf16_t* p = dst + (size_t)row * pitch + head * 64 + 8 * fq;
                    *(u32x4e*)p = pack8v(o1); *(u32x4e*)(p + 32) = pack8v(o2);
                    __builtin_amdgcn_sched_barrier(0);
                }
        } else {
#pragma unroll
            for (int ai = 0; ai < 2; ++ai)
#pragma unroll
                for (int m = 0; m < 4; ++m) { bf16_t* rp = CV + (size_t)(rowb + ai * HALF + m * 16) * 128 + 32 * (wc - 2) + 8 * fq;
#pragma unroll
                    for (int bj = 0; bj < 2; ++bj) { const f32x4 v0 = acc[ai][bj][m][0], v1 = acc[ai][bj][m][1]; u32x4e w; w.x = cvt_pk_bf16(v0[0], v0[1]); w.y = cvt_pk_bf16(v0[2], v0[3]); w.z = cvt_pk_bf16(v1[0], v1[1]); w.w = cvt_pk_bf16(v1[2], v1[3]);
                        *(u32x4e*)(rp + bj * 64) = w; } }
        }
    }
};
__device__ __forceinline__ float sigm(float z) { return __builtin_amdgcn_rcpf(1.0f + __builtin_amdgcn_exp2f(-1.4426950408889634f * z)); }
struct EpiZ {
    static constexpr bool PERM = true, AFTER_DRAIN = false;
    bf16_t* OA;
    __device__ __forceinline__ void operator()(const f32x4 (&acc)[2][2][4][2], const Unit& u, int wr, int wc, int fr, int fq) const {
        const int pn = u.pn; const int rowb = u.pm * BM + wr * 64 + fr;
        bf16_t* O = OA + (size_t)(pn >> 1) * ((size_t)32768 * 512); const int cb = 256 * (pn & 1) + wc * 32 + 8 * fq;
#pragma unroll
        for (int ai = 0; ai < 2; ++ai) {
            u32x4e o[4][2];
#pragma unroll
            for (int m = 0; m < 4; ++m)
#pragma unroll
                for (int bj = 0; bj < 2; ++bj) o[m][bj] = *(const u32x4e*)(O + (size_t)(rowb + ai * HALF + m * 16) * 512 + cb + bj * HALF);
#pragma unroll
            for (int m = 0; m < 4; ++m)
#pragma unroll
                for (int bj = 0; bj < 2; ++bj) { const f32x4 z0 = acc[ai][bj][m][0], z1 = acc[ai][bj][m][1]; const u32x4e ov = o[m][bj];
                    u32x4e w; w.x = cvt_pk_bf16(bf_lo(ov.x) * z0[0] * sigm(z0[0]), bf_hi(ov.x) * z0[1] * sigm(z0[1])); w.y = cvt_pk_bf16(bf_lo(ov.y) * z0[2] * sigm(z0[2]), bf_hi(ov.y) * z0[3] * sigm(z0[3]));
                    w.z = cvt_pk_bf16(bf_lo(ov.z) * z1[0] * sigm(z1[0]), bf_hi(ov.z) * z1[1] * sigm(z1[1])); w.w = cvt_pk_bf16(bf_lo(ov.w) * z1[2] * sigm(z1[2]), bf_hi(ov.w) * z1[3] * sigm(z1[3]));
                    *(u32x4e*)(O + (size_t)(rowb + ai * HALF + m * 16) * 512 + cb + bj * HALF) = w; }
            __builtin_amdgcn_sched_barrier(0);
        }
    }
};
struct EpiG {
    static constexpr bool PERM = true, AFTER_DRAIN = false;
    bf16_t* SG;
    __device__ __forceinline__ void operator()(const f32x4 (&acc)[2][2][4][2], const Unit& u, int wr, int wc, int fr, int fq) const {
        const int rowb = u.pm * BM + wr * 64 + fr; const int cb = 256 * u.pn + wc * 32 + 8 * fq;
#pragma unroll
        for (int ai = 0; ai < 2; ++ai)
#pragma unroll
            for (int m = 0; m < 4; ++m) { bf16_t* rp = SG + (size_t)(rowb + ai * HALF + m * 16) * 3072 + cb;
#pragma unroll
                for (int bj = 0; bj < 2; ++bj) { const f32x4 z0 = acc[ai][bj][m][0], z1 = acc[ai][bj][m][1];
                    u32x4e w; w.x = cvt_pk_bf16(sigm(z0[0]), sigm(z0[1])); w.y = cvt_pk_bf16(sigm(z0[2]), sigm(z0[3])); w.z = cvt_pk_bf16(sigm(z1[0]), sigm(z1[1])); w.w = cvt_pk_bf16(sigm(z1[2]), sigm(z1[3]));
                    *(u32x4e*)(rp + bj * HALF) = w; } }
    }
};
struct EpiBr {
    static constexpr bool PERM = true, AFTER_DRAIN = false;
    const bf16_t* SG; bf16_t* Y;
    __device__ __forceinline__ void operator()(const f32x4 (&acc)[2][2][4][2], const Unit& u, int wr, int wc, int fr, int fq) const {
        const int br = u.pn >> 2;
        const int rowb = (u.pm & 127) * BM + wr * 64 + fr; const int cb = 256 * (u.pn & 3) + wc * 32 + 8 * fq;
#pragma unroll
        for (int ai = 0; ai < 2; ++ai) {
            u32x4e gq[4][2], oq[4][2];
#pragma unroll
            for (int m = 0; m < 4; ++m)
#pragma unroll
                for (int bj = 0; bj < 2; ++bj) { const size_t row = (size_t)(rowb + ai * HALF + m * 16); const int c = cb + bj * HALF;
                    gq[m][bj] = *(const u32x4e*)(SG + row * 3072 + br * 1024 + c); oq[m][bj] = br ? *(const u32x4e*)(Y + row * 1024 + c) : (u32x4e){0u, 0u, 0u, 0u}; }
#pragma unroll
            for (int m = 0; m < 4; ++m)
#pragma unroll
                for (int bj = 0; bj < 2; ++bj) { const size_t row = (size_t)(rowb + ai * HALF + m * 16); const int c = cb + bj * HALF; const f32x4 t0 = acc[ai][bj][m][0], t1 = acc[ai][bj][m][1];
                    const u32x4e g = gq[m][bj], o = oq[m][bj];
                    float y[8] = {bf_lo(g.x) * t0[0] + bf_lo(o.x), bf_hi(g.x) * t0[1] + bf_hi(o.x), bf_lo(g.y) * t0[2] + bf_lo(o.y), bf_hi(g.y) * t0[3] + bf_hi(o.y),
                                  bf_lo(g.z) * t1[0] + bf_lo(o.z), bf_hi(g.z) * t1[1] + bf_hi(o.z), bf_lo(g.w) * t1[2] + bf_lo(o.w), bf_hi(g.w) * t1[3] + bf_hi(o.w)};
                    *(u32x4e*)(Y + row * 1024 + c) = pack8v(y); }
            __builtin_amdgcn_sched_barrier(0);
        }
    }
};
struct BranchOrder {
    int G, c;
    __device__ bool next(int i, Unit& u) const {
        const int t = (i / 3) * G + c; if (t >= 512) return false; const int br = i % 3;
        const int wgid = (t % NXCD) * 64 + t / NXCD; const int pm = (wgid / 32) * 8 + (wgid % 32) % 8, pn = (wgid % 32) / 8;
        u.pm = br * 128 + pm; u.pn = br * 4 + pn; return true; }
    __device__ __forceinline__ void a_ready(const Unit&) const {}
    __device__ __forceinline__ void done(const Unit&) const {}
};
struct EpiOutLn {
    static constexpr bool PERM = true, AFTER_DRAIN = false;
    const float* res; float* out; bf16_t* xb; const float* g; const float* b; unsigned long long* xbuf; unsigned* cnt; float alpha; int write_xb;
    __device__ __forceinline__ void operator()(const f32x4 (&acc)[2][2][4][2], const Unit& u, int wr, int wc, int fr, int fq) const {
        typedef float f32x2v __attribute__((ext_vector_type(2)));
        const int tid = threadIdx.x, lane = tid & 63, wid = tid >> 6;
        PG8_LAS unsigned char* lt = (PG8_LAS unsigned char*)(uintptr_t)131072;
        PG8_LAS f32x2v* P = (PG8_LAS f32x2v*)lt; PG8_LAS f32x2v* S = (PG8_LAS f32x2v*)(lt + 8192); PG8_LAS unsigned* flag = (PG8_LAS unsigned*)(lt + 8192 + 2048);
        const int rowb = u.pm * BM + wr * 64 + fr; const int cb = 256 * u.pn + wc * 32 + 8 * fq;
#pragma unroll
        for (int ai = 0; ai < 2; ++ai) {
            f32x4 rq[4][2][2];
#pragma unroll
            for (int m = 0; m < 4; ++m)
#pragma unroll
                for (int bj = 0; bj < 2; ++bj)
#pragma unroll
                    for (int n = 0; n < 2; ++n) rq[m][bj][n] = *(const f32x4*)(res + (size_t)(rowb + ai * HALF + m * 16) * 1024 + cb + bj * HALF + 4 * n);
#pragma unroll
            for (int m = 0; m < 4; ++m) { const size_t off = (size_t)(rowb + ai * HALF + m * 16) * 1024 + cb;
                f32x4 v[2][2]; float sm = 0.f;
#pragma unroll
                for (int bj = 0; bj < 2; ++bj)
#pragma unroll
                    for (int n = 0; n < 2; ++n) { v[bj][n] = rq[m][bj][n] * alpha + acc[ai][bj][m][n]; sm += (v[bj][n][0] + v[bj][n][1]) + (v[bj][n][2] + v[bj][n][3]); }
#pragma unroll
                for (int bj = 0; bj < 2; ++bj)
#pragma unroll
                    for (int n = 0; n < 2; ++n) *(f32x4*)(out + off + bj * HALF + 4 * n) = v[bj][n];
                sm += __shfl_xor(sm, 16); sm += __shfl_xor(sm, 32);
                const float mw = sm * (1.0f / 64.0f); float q = 0.f;
#pragma unroll
                for (int bj = 0; bj < 2; ++bj)
#pragma unroll
                    for (int n = 0; n < 2; ++n) { const f32x4 d = v[bj][n] - mw; q += (d[0] * d[0] + d[1] * d[1]) + (d[2] * d[2] + d[3] * d[3]); }
                q += __shfl_xor(q, 16); q += __shfl_xor(q, 32);
                if (fq == 0) P[(ai * HALF + wr * 64 + m * 16 + fr) * 4 + wc] = (f32x2v){mw, q};
            }
            __builtin_amdgcn_sched_barrier(0);
        }
        asm volatile("s_waitcnt lgkmcnt(0)" ::: "memory"); __builtin_amdgcn_s_barrier(); asm volatile("" ::: "memory");
        const int row = wid * 32 + (lane & 31);
        if (lane < 32) {
            const f32x2v a = P[row * 4 + 0], b2 = P[row * 4 + 1], c = P[row * 4 + 2], d = P[row * 4 + 3];
            const float mt = (a.x + b2.x + c.x + d.x) * 0.25f;
            const float da = a.x - mt, db = b2.x - mt, dc = c.x - mt, dd = d.x - mt;
            const float m2 = (a.y + b2.y) + (c.y + d.y) + 64.0f * ((da * da + db * db) + (dc * dc + dd * dd));
            unsigned long long* slot = xbuf + ((size_t)(u.pm * BM + row) * 4 + u.pn);
            __hip_atomic_store(slot, ((unsigned long long)__float_as_uint(m2) << 32) | __float_as_uint(mt), __ATOMIC_RELAXED, __HIP_MEMORY_SCOPE_AGENT);
        }
        asm volatile("s_waitcnt vmcnt(0)" ::: "memory");
        if (lane == 0) __hip_atomic_fetch_add(cnt + 64 * u.pm, 1u, __ATOMIC_RELAXED, __HIP_MEMORY_SCOPE_AGENT);
        if (wid == 0) {
            unsigned spins = 0;
            while ((unsigned)__builtin_amdgcn_readfirstlane(__hip_atomic_load(cnt + 64 * u.pm, __ATOMIC_RELAXED, __HIP_MEMORY_SCOPE_AGENT)) < 32u && ++spins < (1u << 24)) __builtin_amdgcn_s_sleep(1);
            __builtin_amdgcn_fence(__ATOMIC_ACQUIRE, "agent");
            if (lane == 0) flag[0] = spins;
        }
        asm volatile("s_waitcnt vmcnt(0) lgkmcnt(0)" ::: "memory"); __builtin_amdgcn_s_barrier(); asm volatile("" ::: "memory");
        if (lane < 32) {
            const unsigned long long* slot = xbuf + (size_t)(u.pm * BM + row) * 4; float mt[4], m2[4]; float ms = 0.f;
#pragma unroll
            for (int t = 0; t < 4; ++t) { const unsigned long long w = __hip_atomic_load(slot + t, __ATOMIC_RELAXED, __HIP_MEMORY_SCOPE_AGENT); mt[t] = __uint_as_float((unsigned)w); m2[t] = __uint_as_float((unsigned)(w >> 32)); ms += mt[t]; }
            const float mean = ms * 0.25f; float q = 0.f;
#pragma unroll
            for (int t = 0; t < 4; ++t) { const float dm = mt[t] - mean; q += m2[t] + 256.0f * dm * dm; }
            S[row] = (f32x2v){mean, 1.0f / sqrtf(q * (1.0f / 1024.0f) + 1e-5f)};
        }
        asm volatile("s_waitcnt lgkmcnt(0)" ::: "memory"); __builtin_amdgcn_s_barrier(); asm volatile("" ::: "memory");
#pragma unroll
        for (int ai = 0; ai < 2; ++ai) {
            f32x4 vq[4][2][2];
#pragma unroll
            for (int m = 0; m < 4; ++m)
#pragma unroll
                for (int bj = 0; bj < 2; ++bj)
#pragma unroll
                    for (int n = 0; n < 2; ++n) vq[m][bj][n] = *(const f32x4*)(out + (size_t)(u.pm * BM + ai * HALF + wr * 64 + m * 16 + fr) * 1024 + cb + bj * HALF + 4 * n);
#pragma unroll
            for (int m = 0; m < 4; ++m) { const int r = ai * HALF + wr * 64 + m * 16 + fr; const f32x2v sr = S[r]; const size_t off = (size_t)(u.pm * BM + r) * 1024 + cb;
#pragma unroll
                for (int bj = 0; bj < 2; ++bj) { const f32x4 g0 = *(const f32x4*)(g + cb + bj * HALF), g1 = *(const f32x4*)(g + cb + bj * HALF + 4), b0 = *(const f32x4*)(b + cb + bj * HALF), b1 = *(const f32x4*)(b + cb + bj * HALF + 4);
                    const f32x4 y0 = (vq[m][bj][0] - sr.x) * sr.y * g0 + b0, y1 = (vq[m][bj][1] - sr.x) * sr.y * g1 + b1;
                    *(f32x4*)(out + off + bj * HALF) = y0; *(f32x4*)(out + off + bj * HALF + 4) = y1;
                    if (write_xb) { u32x4e w; w.x = cvt_pk_bf16(y0[0], y0[1]); w.y = cvt_pk_bf16(y0[2], y0[3]); w.z = cvt_pk_bf16(y1[0], y1[1]); w.w = cvt_pk_bf16(y1[2], y1[3]); *(u32x4e*)(xb + off + bj * HALF) = w; } } }
            __builtin_amdgcn_sched_barrier(0);
        }
    }
};
template <class Epi, class Sched, bool ALIGN_EPI = false, bool SP2 = false>
__device__ __forceinline__ void gemm_phase(PG8_LAS unsigned char* lds, const Gemm g, const Sched& S, const Epi& E) {
    int tid = threadIdx.x; asm volatile("" : "+v"(tid));
    const int wid = __builtin_amdgcn_readfirstlane(tid >> 6), lane = tid & 63, wr = wid >> 2, wc = wid & 3, fr = lane & 15, fq = lane >> 4;
    const int K = g.K, nt = K / BK;
    unsigned voffA[2], voffB[2];
#pragma unroll
    for (int i = 0; i < 2; ++i) { int R, C; stage_rc(tid * 16 + i * 8192, R, C); const int Rb = Epi::PERM ? ((R & ~31) + perm32(R & 31)) : R;
        voffA[i] = (unsigned)(R * K + C) * 2u; voffB[i] = (unsigned)(Rb * K + C) * 2u; }
    const size_t kstep = (size_t)(BK * 2);
    const size_t hstep = (size_t)HALF * K * 2;
    const size_t tstep = 2 * hstep;
    const unsigned ldsw = (unsigned)wid * 1024u;
    const int aoff = lds_byte(wr * 64 + fr, fq * 8), boff = lds_byte(wc * 32 + fr, fq * 8);
#define PG8_SA(b, h) (((b) * 2 + (h)) * HTB)
#define PG8_SB(b, h) ((4 + (b) * 2 + (h)) * HTB)
#define PG8_STAGE(bufoff, gbase, voff) do { _Pragma("unroll") for (int _i = 0; _i < 2; ++_i) \
        __builtin_amdgcn_global_load_lds((const unsigned*)((const char*)(gbase) + (voff)[_i]), (PG8_LAS unsigned*)(lds + (bufoff) + ldsw + _i * 8192), 16, 0, 0); } while (0)
#define PG8_LDA(dst, b, h) do { _Pragma("unroll") for (int m = 0; m < 4; ++m) _Pragma("unroll") for (int k = 0; k < 2; ++k) dst[m][k] = *(const PG8_LAS bf16x8*)(lds + PG8_SA(b, h) + aoff + m * 2048 + k * 1024); } while (0)
#define PG8_LDB(dst, b, h) do { _Pragma("unroll") for (int n = 0; n < 2; ++n) _Pragma("unroll") for (int k = 0; k < 2; ++k) dst[n][k] = *(const PG8_LAS bf16x8*)(lds + PG8_SB(b, h) + boff + n * 2048 + k * 1024); } while (0)
#define PG8_MMA(ai, bj, At, Bt) do { __builtin_amdgcn_s_setprio(1); _Pragma("unroll") for (int m = 0; m < 4; ++m) _Pragma("unroll") for (int n = 0; n < 2; ++n) _Pragma("unroll") for (int k = 0; k < 2; ++k) \
        acc[ai][bj][m][n] = __builtin_amdgcn_mfma_f32_16x16x32_bf16(Bt[n][k], At[m][k], acc[ai][bj][m][n], 0, 0, 0); __builtin_amdgcn_s_setprio(0); } while (0)
#define PG8_WAIT_V(n) asm volatile("s_waitcnt vmcnt(" #n ")" ::: "memory")
#define PG8_WAIT_L(n) asm volatile("s_waitcnt lgkmcnt(" #n ")" ::: "memory")
#define PG8_BAR __builtin_amdgcn_s_barrier()
#define PG8_SCHED __builtin_amdgcn_sched_barrier(0)
    Unit cur, nxt; int ui = 0;
    if (!S.next(0, cur)) return;
    f32x4 acc[2][2][4][2];
#pragma unroll
    for (int a = 0; a < 2; ++a)
#pragma unroll
        for (int b = 0; b < 2; ++b)
#pragma unroll
            for (int m = 0; m < 4; ++m)
#pragma unroll
                for (int n = 0; n < 2; ++n) acc[a][b][m][n] = (f32x4){0.f, 0.f, 0.f, 0.f};
    bf16x8 At[4][2], B0[2][2], B1[2][2];
    const char* cA = (const char*)g.A + (size_t)cur.pm * tstep; const char* cB = (const char*)g.Bt + (size_t)cur.pn * tstep;
    S.a_ready(cur);
    if constexpr (SP2) {
        PG8_STAGE(PG8_SB(0, 0), cB, voffB); PG8_STAGE(PG8_SB(0, 1), cB + hstep, voffB); PG8_STAGE(PG8_SA(0, 0), cA, voffA); PG8_STAGE(PG8_SA(0, 1), cA + hstep, voffA);
        if (wr == 1) PG8_BAR;
        PG8_WAIT_V(2); PG8_BAR;
        PG8_STAGE(PG8_SB(1, 0), cB + kstep, voffB); PG8_STAGE(PG8_SA(1, 0), cA + kstep, voffA); PG8_STAGE(PG8_SB(1, 1), cB + hstep + kstep, voffB);
        PG8_WAIT_V(6); PG8_BAR;
    } else {
        PG8_STAGE(PG8_SB(0, 0), cB, voffB); PG8_STAGE(PG8_SA(0, 0), cA, voffA); PG8_STAGE(PG8_SB(0, 1), cB + hstep, voffB); PG8_STAGE(PG8_SA(0, 1), cA + hstep, voffA);
        if (wr == 1) PG8_BAR;
        PG8_WAIT_V(4); PG8_BAR;
        PG8_STAGE(PG8_SB(1, 0), cB + kstep, voffB); PG8_STAGE(PG8_SA(1, 0), cA + kstep, voffA); PG8_STAGE(PG8_SB(1, 1), cB + hstep + kstep, voffB);
        PG8_WAIT_V(6); PG8_BAR;
    }
    for (;;) {
        const bool has_next = S.next(ui + 1, nxt);
        const char* nA = has_next ? (const char*)g.A + (size_t)nxt.pm * tstep : cA; const char* nB = has_next ? (const char*)g.Bt + (size_t)nxt.pn * tstep : cB;
        for (int t = 0; t < nt; t += 2) {
            const bool last = (t == nt - 2);
            const char* a1 = cA + (size_t)(t + 1) * kstep;
            const char* a2 = last ? nA : cA + (size_t)(t + 2) * kstep; const char* b2 = last ? nB : cB + (size_t)(t + 2) * kstep;
            const char* a3 = a2 + kstep; const char* b3 = b2 + kstep;
            if (last && has_next) S.a_ready(nxt);
            if constexpr (SP2) {
            PG8_LDB(B0, 0, 0); PG8_LDB(B1, 0, 1); PG8_SCHED; PG8_LDA(At, 0, 0); PG8_STAGE(PG8_SA(1, 1), a1 + hstep, voffA);
            PG8_WAIT_V(8); PG8_WAIT_L(0); PG8_BAR; PG8_MMA(0, 0, At, B0); PG8_MMA(0, 1, At, B1); PG8_BAR; PG8_SCHED;
            PG8_LDA(At, 0, 1); PG8_STAGE(PG8_SB(0, 0), b2, voffB); PG8_STAGE(PG8_SB(0, 1), b2 + hstep, voffB); PG8_STAGE(PG8_SA(0, 0), a2, voffA);
            PG8_WAIT_V(8); PG8_WAIT_L(0); PG8_BAR; PG8_MMA(1, 0, At, B0); PG8_MMA(1, 1, At, B1); PG8_BAR; PG8_SCHED;
            PG8_LDB(B0, 1, 0); PG8_LDB(B1, 1, 1); PG8_SCHED; PG8_LDA(At, 1, 0); PG8_STAGE(PG8_SA(0, 1), a2 + hstep, voffA);
            PG8_WAIT_V(8); PG8_WAIT_L(0); PG8_BAR; PG8_MMA(0, 0, At, B0); PG8_MMA(0, 1, At, B1); PG8_BAR; PG8_SCHED;
            PG8_LDA(At, 1, 1); PG8_STAGE(PG8_SB(1, 0), b3, voffB); PG8_STAGE(PG8_SB(1, 1), b3 + hstep, voffB); PG8_STAGE(PG8_SA(1, 0), a3, voffA);
            PG8_WAIT_V(8); PG8_WAIT_L(0); PG8_BAR; PG8_MMA(1, 0, At, B0); PG8_MMA(1, 1, At, B1); PG8_BAR; PG8_SCHED;
            } else {
            PG8_LDB(B0, 0, 0); PG8_SCHED; PG8_LDA(At, 0, 0); PG8_STAGE(PG8_SA(1, 1), a1 + hstep, voffA);
            PG8_WAIT_L(8); PG8_BAR; PG8_WAIT_L(0); PG8_MMA(0, 0, At, B0); PG8_BAR; PG8_SCHED;
            PG8_LDB(B1, 0, 1); PG8_STAGE(PG8_SB(0, 0), b2, voffB);
            PG8_BAR; PG8_WAIT_L(0); PG8_MMA(0, 1, At, B1); PG8_BAR;
            PG8_LDA(At, 0, 1); PG8_STAGE(PG8_SA(0, 0), a2, voffA);
            PG8_BAR; PG8_WAIT_L(0); PG8_MMA(1, 0, At, B0); PG8_BAR; PG8_SCHED;
            PG8_STAGE(PG8_SB(0, 1), b2 + hstep, voffB);
            PG8_WAIT_V(6); PG8_BAR; PG8_MMA(1, 1, At, B1); PG8_BAR;
            PG8_LDB(B0, 1, 0); PG8_SCHED; PG8_LDA(At, 1, 0); PG8_STAGE(PG8_SA(0, 1), a2 + hstep, voffA);
            PG8_WAIT_L(8); PG8_BAR; PG8_WAIT_L(0); PG8_MMA(0, 0, At, B0); PG8_BAR; PG8_SCHED;
            PG8_LDB(B1, 1, 1); PG8_STAGE(PG8_SB(1, 0), b3, voffB);
            PG8_BAR; PG8_WAIT_L(0); PG8_MMA(0, 1, At, B1); PG8_BAR;
            PG8_LDA(At, 1, 1); PG8_STAGE(PG8_SA(1, 0), a3, voffA);
            PG8_BAR; PG8_WAIT_L(0); PG8_MMA(1, 0, At, B0); PG8_BAR; PG8_SCHED;
            PG8_STAGE(PG8_SB(1, 1), b3 + hstep, voffB);
            PG8_WAIT_V(6); PG8_BAR; PG8_MMA(1, 1, At, B1); PG8_BAR;
            }
        }
        if constexpr (ALIGN_EPI) { if (wr == 0) PG8_BAR; }
        if constexpr (!Epi::AFTER_DRAIN) { E(acc, cur, wr, wc, fr, fq); S.done(cur); }
        if (!has_next) break;
#pragma unroll
        for (int a = 0; a < 2; ++a)
#pragma unroll
            for (int b = 0; b < 2; ++b)
#pragma unroll
                for (int m = 0; m < 4; ++m)
#pragma unroll
                    for (int n = 0; n < 2; ++n) acc[a][b][m][n] = (f32x4){0.f, 0.f, 0.f, 0.f};
        cur = nxt; cA = nA; cB = nB; ++ui;
        if constexpr (ALIGN_EPI) { if (wr == 1) PG8_BAR; }
    }
    PG8_WAIT_V(0);
    if constexpr (!ALIGN_EPI) { if (wr == 0) PG8_BAR; }
    PG8_BAR;
    if constexpr (Epi::AFTER_DRAIN) { E.fused(acc, cur, wr, wc, fr, fq, lds, wid, lane); S.done(cur); }
#undef PG8_SA
#undef PG8_SB
#undef PG8_STAGE
#undef PG8_LDA
#undef PG8_LDB
#undef PG8_MMA
#undef PG8_WAIT_V
#undef PG8_WAIT_L
#undef PG8_BAR
#undef PG8_SCHED
}
}
#include <hip/hip_bf16.h>
#include <cmath>
namespace attn_body {
using bf16=__hip_bfloat16;
using bf16x8=__attribute__((ext_vector_type(8)))short;
using s16x4=__attribute__((ext_vector_type(4)))short;
using f32x16=__attribute__((ext_vector_type(16)))float;
using u32x4=__attribute__((ext_vector_type(4)))unsigned;
constexpr int BATCH=2,NHEAD=8,SEQ=16384,D=64,QP=512,KP=128,GQ=4;
constexpr int NW=8,QBLK=32,QB=QBLK*NW,KVBLK=64,NQB=SEQ/QB;
constexpr int ATTN_UNIT_ROWS=QB;
__device__ __forceinline__ int crow(int r,int hi){return (r&3)+8*(r>>2)+4*hi;}
#define SBAR() __builtin_amdgcn_sched_barrier(0)
constexpr int NSLOT=3, SLOTB=8192;
constexpr int LDS_K=0, LDS_V=NSLOT*SLOTB, LDS_WS=2*NSLOT*SLOTB, LDS_OST=LDS_WS+NW*64*4, LDS_BYTES=LDS_OST+NW*4096;
constexpr float C2=0.125f*1.4426950408889634f;
__device__ __forceinline__ void glds16(const void*gsrc,unsigned lds_dst){unsigned keep;
  asm volatile("s_mov_b32 %0, m0\n\ts_mov_b32 m0, %2\n\ts_nop 0\n\tglobal_load_lds_dwordx4 %1, off\n\ts_mov_b32 m0, %0":"=&s"(keep):"v"(gsrc),"s"(lds_dst):"memory");}
__device__ __forceinline__ float fadd_s(float a,float b){float r;asm("v_add_f32_e32 %0, %1, %2":"=v"(r):"v"(a),"v"(b));return r;}
__device__ __forceinline__ float fsub_s(float a,float b){float r;asm("v_sub_f32_e32 %0, %1, %2":"=v"(r):"v"(a),"v"(b));return r;}
typedef float f32x2_t __attribute__((ext_vector_type(2))); typedef __bf16 bf16x2_t __attribute__((ext_vector_type(2)));
__device__ __forceinline__ unsigned cvtpk_s(float lo,float hi){f32x2_t v={lo,hi};bf16x2_t b=__builtin_convertvector(v,bf16x2_t);return __builtin_bit_cast(unsigned,b);}
#define WAIT_BAR(N) asm volatile("s_waitcnt vmcnt(" #N ") lgkmcnt(0)\n\ts_barrier":::"memory")

__device__ __forceinline__ void qkt(f32x16&p0,f32x16&p1,const char*Kslot,const bf16x8*qr,const f32x16&negm,int r32,int hi){
  const char*kb=Kslot+hi*1024+r32*16;
  #pragma unroll
  for(int d0=0;d0<4;++d0){
    const bf16x8 b0=*reinterpret_cast<const bf16x8*>(kb+d0*2048);
    const bf16x8 b1=*reinterpret_cast<const bf16x8*>(kb+d0*2048+512);
    if(d0==0){p0=__builtin_amdgcn_mfma_f32_32x32x16_bf16(b0,qr[0],negm,0,0,0);p1=__builtin_amdgcn_mfma_f32_32x32x16_bf16(b1,qr[0],negm,0,0,0);}
    else{p0=__builtin_amdgcn_mfma_f32_32x32x16_bf16(b0,qr[d0],p0,0,0,0);p1=__builtin_amdgcn_mfma_f32_32x32x16_bf16(b1,qr[d0],p1,0,0,0);}}
}
typedef __attribute__((address_space(3))) const char* lds_cptr;
typedef short v4i16_t __attribute__((ext_vector_type(4)));
__device__ __forceinline__ void kload8(bf16x8*kf,lds_cptr kp){
  kf[0]=*(const __attribute__((address_space(3))) bf16x8*)(kp);      kf[1]=*(const __attribute__((address_space(3))) bf16x8*)(kp+512);
  kf[2]=*(const __attribute__((address_space(3))) bf16x8*)(kp+2048); kf[3]=*(const __attribute__((address_space(3))) bf16x8*)(kp+2560);
  kf[4]=*(const __attribute__((address_space(3))) bf16x8*)(kp+4096); kf[5]=*(const __attribute__((address_space(3))) bf16x8*)(kp+4608);
  kf[6]=*(const __attribute__((address_space(3))) bf16x8*)(kp+6144); kf[7]=*(const __attribute__((address_space(3))) bf16x8*)(kp+6656);
}
__device__ __forceinline__ void kload2(bf16x8*kf,lds_cptr kp,int j){ kf[2*j]=*(const __attribute__((address_space(3))) bf16x8*)(kp+j*2048); kf[2*j+1]=*(const __attribute__((address_space(3))) bf16x8*)(kp+j*2048+512); }
__device__ __forceinline__ s16x4 vtr(lds_cptr p){ return __builtin_bit_cast(s16x4,__builtin_amdgcn_ds_read_tr16_b64_v4i16((__attribute__((address_space(3))) v4i16_t*)p)); }
__device__ __forceinline__ void pv(f32x16*o,int vb,bf16x8 pa0,bf16x8 pa1,bf16x8 pa2,bf16x8 pa3){
  #pragma unroll
  for(int d0=0;d0<2;++d0){s16x4 lo[4],hi[4];
    #pragma unroll
    for(int ks=0;ks<4;++ks){
      asm volatile("ds_read_b64_tr_b16 %0,%1 offset:%c2":"=&v"(lo[ks]):"v"(vb),"i"(d0*4096+ks*1024):"memory");
      asm volatile("ds_read_b64_tr_b16 %0,%1 offset:%c2":"=&v"(hi[ks]):"v"(vb),"i"(d0*4096+ks*1024+512):"memory");}
    asm volatile("s_waitcnt lgkmcnt(0)":::"memory");SBAR();
    #define PK(k) (bf16x8){lo[k][0],lo[k][1],lo[k][2],lo[k][3],hi[k][0],hi[k][1],hi[k][2],hi[k][3]}
    o[d0]=__builtin_amdgcn_mfma_f32_32x32x16_bf16(pa0,PK(0),o[d0],0,0,0);
    o[d0]=__builtin_amdgcn_mfma_f32_32x32x16_bf16(pa1,PK(1),o[d0],0,0,0);
    o[d0]=__builtin_amdgcn_mfma_f32_32x32x16_bf16(pa2,PK(2),o[d0],0,0,0);
    o[d0]=__builtin_amdgcn_mfma_f32_32x32x16_bf16(pa3,PK(3),o[d0],0,0,0);
    #undef PK
  }
}

#ifndef ATTN_STORE16
#define ATTN_STORE16(p,v) (*(u32x4*)(p)=(v))
#endif
template<int THRL> __device__ __forceinline__ void attn_unit(int b,int h,int qb,const bf16*Q,const bf16*__restrict__ K,const bf16*__restrict__ V,bf16*O,char*shm,const float Mref){
  int tid=threadIdx.x; asm volatile("":"+v"(tid)); const int lane=tid&63,r32=lane&31,hi=lane>>5; const int wid=__builtin_amdgcn_readfirstlane(tid>>6);
  const long rowbase=(long)b*SEQ; const int q0=qb*QB;
  const bf16*Qw=Q+(rowbase+q0+wid*QBLK)*QP+h*D;
  const bf16*Kh=K+rowbase*KP+(h/GQ)*D,*Vh=V+rowbase*KP+(h/GQ)*D;
  const unsigned lds0=(unsigned)(uintptr_t)shm;
  float*wsf=(float*)(shm+LDS_WS)+wid*64;
  const bf16*ksrc=Kh+(long)lane*KP+wid*8;
  const bf16*vsrc=Vh+(long)(16*(wid&3)+(lane>>2))*KP+(wid>>2)*32+(lane&3)*8;
  const unsigned kdst=lds0+LDS_K+wid*1024, vdst=lds0+LDS_V+wid*1024;
  #define DMA_K(t,slot) glds16(ksrc+(long)(t)*KVBLK*KP,(unsigned)__builtin_amdgcn_readfirstlane(kdst+(slot)))
  #define DMA_V(t,slot) glds16(vsrc+(long)(t)*KVBLK*KP,(unsigned)__builtin_amdgcn_readfirstlane(vdst+(slot)))
  const int vb0=(int)(lds0+LDS_V)+((lane>>4)&1)*32+(lane&3)*8+(4*hi+((lane&15)>>2))*64;
  const char*Kbase=shm+LDS_K; bf16x8 kf[8];
  const lds_cptr shm3=(lds_cptr)shm; const lds_cptr kp0=shm3+LDS_K+hi*1024+r32*16; const lds_cptr vp0=shm3+LDS_V+((lane>>4)&1)*32+(lane&3)*8+(4*hi+((lane&15)>>2))*64;
  const int NT=SEQ/KVBLK;
  DMA_K(0,0);DMA_V(0,0);DMA_K(1,SLOTB);
  bf16x8 qr[4];
  #pragma unroll
  for(int d0=0;d0<4;++d0)qr[d0]=*reinterpret_cast<const bf16x8*>(&Qw[(long)r32*QP+d0*16+hi*8]);
  float mhat=0.f,l_reg=0.f;f32x16 o[2];o[0]=f32x16{};o[1]=f32x16{};f32x16 negm=f32x16{};asm volatile("":"+v"(negm));
  #define CMASK(P0,P1,t) do{}while(0)
  bool resc=false;
  #define START(P0,P1) do{ const float rm=Mref; resc=false; \
    { const float dl=rm; mhat=fadd_s(mhat,dl); \
      _Pragma("unroll") for(int r=0;r<16;++r){P0[r]=fsub_s(P0[r],dl);P1[r]=fsub_s(P1[r],dl);} \
      _Pragma("unroll") for(int r=0;r<16;++r)negm[r]=-mhat; asm volatile("":"+v"(negm)); } \
    _Pragma("unroll") for(int r=0;r<16;++r)P0[r]=__builtin_amdgcn_exp2f(P0[r]); }while(0)
  #define RESC() do{}while(0)
  f32x16 pA0,pA1,pB0,pB1;
  int sl_prev=0,sl_cur=0,sl_next=SLOTB;
  #define ROT() do{sl_prev=sl_cur;sl_cur=sl_next;sl_next=(sl_next==(NSLOT-1)*SLOTB)?0:sl_next+SLOTB;}while(0)
  DMA_K(2,2*SLOTB);
  WAIT_BAR(3);
  qkt(pA0,pA1,Kbase,qr,negm,r32,hi);asm volatile("s_nop 15\n\ts_nop 7":"+v"(pA0),"+v"(pA1));CMASK(pA0,pA1,0);
  START(pA0,pA1);
  _Pragma("unroll") for(int r=0;r<16;++r)pA1[r]=__builtin_amdgcn_exp2f(pA1[r]);
  WAIT_BAR(0);
  DMA_K(3,0);DMA_V(1,SLOTB);
  ROT();
  kload8(kf,kp0+sl_cur);
  WAIT_BAR(2);
  s16x4 vlo[8],vhi[8]; u32x4 pw0,pw1,pw2,pw3;
  #define PKW(P,B) cvtpk_s(P[B],P[B+1])
  #define PAF(k) __builtin_bit_cast(bf16x8,pw##k)
  #define VFR(i) (bf16x8){vlo[i][0],vlo[i][1],vlo[i][2],vlo[i][3],vhi[i][0],vhi[i][1],vhi[i][2],vhi[i][3]}
  #define PIN(x) asm volatile("":"+v"(x))
  #define GAPA(MF,A0,A1,A2,A3,W0,W1,PW) do{ MF; sacc+=A0; sacc+=A1; sacc+=A2; sacc+=A3; PIN(sacc); W0; W1; PIN(PW); SBAR(); }while(0)
  #define EX(v) __builtin_amdgcn_exp2f(v)
  #define GAPB(MF,X,B) do{ MF; X[B]=EX(X[B]); X[B+1]=EX(X[B+1]); X[B+2]=EX(X[B+2]); X[B+3]=EX(X[B+3]); PIN(X); SBAR(); }while(0)
  #define VRD(i) do{ vlo[i]=vtr(vp_+(((i)>>2)*4096+((i)&3)*1024)); vhi[i]=vtr(vp_+(((i)>>2)*4096+((i)&3)*1024+512)); }while(0)
  #define KRD(G,j) do{ if(G){ kload2(kf,kp0+sl_next,j); SBAR(); } }while(0)
  #define STEP(C0,C1,P0,P1,t,GK,GV,GL) do{ SBAR(); \
    const lds_cptr vp_=vp0+sl_prev; \
    VRD(0); SBAR(); float sacc=(P0[0]+P0[1]); \
    GAPA(C0=__builtin_amdgcn_mfma_f32_32x32x16_bf16(kf[0],qr[0],negm,0,0,0), P0[2],P0[3],P0[4],P0[5],     pw0[0]=PKW(P0,0), pw0[1]=PKW(P0,2), pw0); \
    VRD(4); SBAR(); GAPA(C1=__builtin_amdgcn_mfma_f32_32x32x16_bf16(kf[1],qr[0],negm,0,0,0), P0[6],P0[7],P0[8],P0[9],     pw0[2]=PKW(P0,4), pw0[3]=PKW(P0,6), pw0); \
    VRD(1); SBAR(); GAPA(C0=__builtin_amdgcn_mfma_f32_32x32x16_bf16(kf[2],qr[1],C0,0,0,0),   P0[10],P0[11],P0[12],P0[13], pw1[0]=PKW(P0,8), pw1[1]=PKW(P0,10), pw1); \
    VRD(5); SBAR(); GAPA(C1=__builtin_amdgcn_mfma_f32_32x32x16_bf16(kf[3],qr[1],C1,0,0,0),   P0[14],P0[15],P1[0],P1[1],   pw1[2]=PKW(P0,12),pw1[3]=PKW(P0,14), pw1); \
    VRD(2); SBAR(); GAPA(C0=__builtin_amdgcn_mfma_f32_32x32x16_bf16(kf[4],qr[2],C0,0,0,0),   P1[2],P1[3],P1[4],P1[5],     pw2[0]=PKW(P1,0), pw2[1]=PKW(P1,2), pw2); \
    VRD(6); SBAR(); GAPA(C1=__builtin_amdgcn_mfma_f32_32x32x16_bf16(kf[5],qr[2],C1,0,0,0),   P1[6],P1[7],P1[8],P1[9],     pw2[2]=PKW(P1,4), pw2[3]=PKW(P1,6), pw2); \
    VRD(3); SBAR(); GAPA(C0=__builtin_amdgcn_mfma_f32_32x32x16_bf16(kf[6],qr[3],C0,0,0,0),   P1[10],P1[11],P1[12],P1[13], pw3[0]=PKW(P1,8), pw3[1]=PKW(P1,10), pw3); \
    VRD(7); SBAR(); GAPA(C1=__builtin_amdgcn_mfma_f32_32x32x16_bf16(kf[7],qr[3],C1,0,0,0),   P1[14],P1[15],0.f,0.f,       pw3[2]=PKW(P1,12),pw3[3]=PKW(P1,14), pw3); \
    l_reg+=sacc; \
    if(GK){DMA_K((t)+3,sl_cur);} if(GV){DMA_V((t)+1,sl_next);} \
    CMASK(C0,C1,t); \
    SBAR(); \
    GAPB(o[0]=__builtin_amdgcn_mfma_f32_32x32x16_bf16(PAF(0),VFR(0),o[0],0,0,0), C0,0); \
    GAPB(o[1]=__builtin_amdgcn_mfma_f32_32x32x16_bf16(PAF(0),VFR(4),o[1],0,0,0), C0,4); \
    KRD(GL,0); GAPB(o[0]=__builtin_amdgcn_mfma_f32_32x32x16_bf16(PAF(1),VFR(1),o[0],0,0,0), C0,8); \
    KRD(GL,1); GAPB(o[1]=__builtin_amdgcn_mfma_f32_32x32x16_bf16(PAF(1),VFR(5),o[1],0,0,0), C0,12); \
    KRD(GL,2); GAPB(o[0]=__builtin_amdgcn_mfma_f32_32x32x16_bf16(PAF(2),VFR(2),o[0],0,0,0), C1,0); \
    KRD(GL,3); GAPB(o[1]=__builtin_amdgcn_mfma_f32_32x32x16_bf16(PAF(2),VFR(6),o[1],0,0,0), C1,4); \
    GAPB(o[0]=__builtin_amdgcn_mfma_f32_32x32x16_bf16(PAF(3),VFR(3),o[0],0,0,0), C1,8); \
    GAPB(o[1]=__builtin_amdgcn_mfma_f32_32x32x16_bf16(PAF(3),VFR(7),o[1],0,0,0), C1,12); \
    }while(0)
  if(wid>=4)__builtin_amdgcn_s_setprio(1);
  int t=1;
  #undef CMASK
  #define CMASK(P0,P1,t) do{}while(0)
  for(;t+5<NT;t+=2){
    STEP(pB0,pB1,pA0,pA1,t,true,true,true);     WAIT_BAR(2); RESC(); ROT();
    STEP(pA0,pA1,pB0,pB1,t+1,true,true,true);   WAIT_BAR(2); RESC(); ROT();
  }
  #undef CMASK
  #define CMASK(P0,P1,t) do{}while(0)
  #define ENDW(tt) do{ if((tt)+3<NT){WAIT_BAR(2);} else if((tt)+2<NT){WAIT_BAR(1);} else {WAIT_BAR(0);} }while(0)
  for(;t+1<NT;t+=2){
    STEP(pB0,pB1,pA0,pA1,t,(t+3<NT),(t+1<NT),(t+1<NT));       ENDW(t);   RESC(); ROT();
    STEP(pA0,pA1,pB0,pB1,t+1,(t+4<NT),(t+2<NT),(t+2<NT));     ENDW(t+1); RESC(); ROT();
  }
  STEP(pB0,pB1,pA0,pA1,NT-1,false,false,false); RESC();
  { float sacc=pB0[0]+pB0[1]; _Pragma("unroll") for(int r=2;r<16;++r)sacc+=pB0[r]; _Pragma("unroll") for(int r=0;r<16;++r)sacc+=pB1[r]; l_reg+=sacc;
    pw0=(u32x4){PKW(pB0,0),PKW(pB0,2),PKW(pB0,4),PKW(pB0,6)};pw1=(u32x4){PKW(pB0,8),PKW(pB0,10),PKW(pB0,12),PKW(pB0,14)};pw2=(u32x4){PKW(pB1,0),PKW(pB1,2),PKW(pB1,4),PKW(pB1,6)};pw3=(u32x4){PKW(pB1,8),PKW(pB1,10),PKW(pB1,12),PKW(pB1,14)};
    SBAR(); pv(o,vb0+sl_cur,PAF(0),PAF(1),PAF(2),PAF(3)); }
  #undef PKW
  #undef PAF
  #undef VFR
  #undef PIN
  #undef GAPA
  #undef GAPB
  #undef EX
  #undef VRD
  #undef KRD
  #undef STEP
  #undef ENDW
  __builtin_amdgcn_s_setprio(0);
  {auto rr=__builtin_amdgcn_permlane32_swap(__float_as_uint(l_reg),__float_as_uint(l_reg),false,false);l_reg=__uint_as_float(rr[0])+__uint_as_float(rr[1]);}
  if(hi==0)wsf[32+r32]=l_reg;asm volatile("s_waitcnt lgkmcnt(0)":::"memory");
  float rli[16];
  #pragma unroll
  for(int r=0;r<16;++r)rli[r]=__builtin_amdgcn_rcpf(wsf[32+crow(r,hi)]);
  bf16*Ow=O+(rowbase+q0+wid*QBLK)*QP+h*D;
  { bf16*stg=(bf16*)(shm+LDS_OST)+wid*2048;
    #pragma unroll
    for(int r=0;r<16;++r){const int orow=crow(r,hi);
      #pragma unroll
      for(int d0=0;d0<2;++d0)stg[orow*64+d0*32+r32]=__float2bfloat16(o[d0][r]*rli[r]);}
    asm volatile("s_waitcnt lgkmcnt(0)":::"memory");
    #pragma unroll
    for(int i=0;i<4;++i){const int row=i*8+(lane>>3),ch=lane&7; const u32x4 v=*(const u32x4*)(stg+row*64+ch*8); ATTN_STORE16(Ow+(long)row*QP+ch*8,v);} }
  asm volatile("s_waitcnt lgkmcnt(0)\n\ts_barrier":::"memory");
  #undef DMA_K
  #undef DMA_V
  #undef CMASK
  #undef START
  #undef RESC
  #undef ROT
}
constexpr int ATTN_LDS_BYTES=LDS_BYTES;
struct AttnTensors { const bf16* Q; const bf16* K; const bf16* V; bf16* O; };
template<int THRL=8> __device__ __forceinline__ void attn_phase(char*lds,const AttnTensors&T,int vcu,int G,const float Mref){
  constexpr int NU=BATCH*NHEAD*NQB; const bool packed=(G*4==NU);
  for(int i=0;;++i){ const int u=packed?((i<4)?vcu*4+i:NU):(vcu+i*G); if(u>=NU)break; const int bh=u/NQB, qb=u%NQB; attn_unit<THRL>(bh/NHEAD,bh%NHEAD,qb,T.Q,T.K,T.V,T.O,lds,Mref); }
}
#undef SBAR
#undef WAIT_BAR
}
namespace mix {
typedef unsigned short bf16_t;
typedef short bf16x8 __attribute__((ext_vector_type(8)));
typedef float f32x4 __attribute__((ext_vector_type(4)));
typedef unsigned u32x4 __attribute__((ext_vector_type(4)));
constexpr int L = 16384;
#define RLAS __attribute__((address_space(3)))
#define MFMA16(a, b, c) __builtin_amdgcn_mfma_f32_16x16x32_bf16(a, b, c, 0, 0, 0)
__device__ __forceinline__ unsigned pk(float lo, float hi) { return pg8::cvt_pk_bf16(lo, hi); }
__device__ __forceinline__ bf16x8 ld8(const bf16_t* p) { return *(const bf16x8*)p; }
__device__ __forceinline__ bf16x8 pack8(float a0, float a1, float a2, float a3, float a4, float a5, float a6, float a7) {
    u32x4 w; w.x = pk(a0, a1); w.y = pk(a2, a3); w.z = pk(a4, a5); w.w = pk(a6, a7); return __builtin_bit_cast(bf16x8, w); }
__device__ __forceinline__ bf16_t bf1(float f) { return (bf16_t)(pk(f, 0.f) & 0xffffu); }
__device__ __forceinline__ float log2_sigmoid(float th) { return -log1pf(expf(-th)) * 1.4426950408889634f; }

__device__ __forceinline__ void ret_kv_block(int cu, int tid, RLAS unsigned char* lds, const bf16_t* RKT, const bf16_t* RVT, bf16_t* ST, const float* thf, const float* thb) {
    const int b = cu >> 9, h = (cu >> 7) & 3, n = cu & 127; const int lane = tid & 63, w = tid >> 6, g = lane >> 4, c16 = lane & 15, eb = w & 3, dh = w >> 2;
    const float l2f = log2_sigmoid(thf[h]), l2b = log2_sigmoid(thb[h]);
    {
        bf16x8 kq[4], vq[4];
#pragma unroll
        for (int i = 0; i < 4; ++i) { const int p = tid + 512 * i, row = p >> 4, cc = p & 15; const size_t src = ((size_t)((b * 4 + h) * 128 + row)) * L + n * 128 + cc * 8;
            kq[i] = ld8(RKT + src); vq[i] = ld8(RVT + src); }
#pragma unroll
        for (int i = 0; i < 4; ++i) { const int p = tid + 512 * i, row = p >> 4, cc = p & 15;
            *(RLAS bf16x8*)(lds + row * 256 + ((cc ^ (row & 15)) << 4)) = kq[i];
            *(RLAS bf16x8*)(lds + 32768 + row * 256 + ((cc ^ (row & 15)) << 4)) = vq[i]; }
    }
    __syncthreads();
    f32x4 aF[2][4], aB[2][4];
#pragma unroll
    for (int et = 0; et < 2; ++et)
#pragma unroll
        for (int dt = 0; dt < 4; ++dt) { aF[et][dt] = (f32x4){0.f, 0.f, 0.f, 0.f}; aB[et][dt] = (f32x4){0.f, 0.f, 0.f, 0.f}; }
#pragma unroll
    for (int ks = 0; ks < 4; ++ks) {
        float wf[8], wb[8];
#pragma unroll
        for (int jj = 0; jj < 8; ++jj) { const int j = ks * 32 + 8 * g + jj; wf[jj] = __builtin_amdgcn_exp2f((float)(127 - j) * l2f); wb[jj] = __builtin_amdgcn_exp2f((float)j * l2b); }
        bf16x8 Af[2], Ab[2];
#pragma unroll
        for (int et = 0; et < 2; ++et) { const int row = eb * 32 + et * 16 + c16;
            const u32x4 v = __builtin_bit_cast(u32x4, *(const RLAS bf16x8*)(lds + 32768 + row * 256 + (((ks * 4 + g) ^ (row & 15)) << 4)));
            float x[8] = {pg8::bf_lo(v.x), pg8::bf_hi(v.x), pg8::bf_lo(v.y), pg8::bf_hi(v.y), pg8::bf_lo(v.z), pg8::bf_hi(v.z), pg8::bf_lo(v.w), pg8::bf_hi(v.w)};
            Af[et] = pack8(x[0] * wf[0], x[1] * wf[1], x[2] * wf[2], x[3] * wf[3], x[4] * wf[4], x[5] * wf[5], x[6] * wf[6], x[7] * wf[7]);
            Ab[et] = pack8(x[0] * wb[0], x[1] * wb[1], x[2] * wb[2], x[3] * wb[3], x[4] * wb[4], x[5] * wb[5], x[6] * wb[6], x[7] * wb[7]); }
#pragma unroll
        for (int dt = 0; dt < 4; ++dt) { const int row = dh * 64 + dt * 16 + c16; const bf16x8 bk = *(const RLAS bf16x8*)(lds + row * 256 + (((ks * 4 + g) ^ (row & 15)) << 4));
#pragma unroll
            for (int et = 0; et < 2; ++et) { aF[et][dt] = MFMA16(bk, Af[et], aF[et][dt]); aB[et][dt] = MFMA16(bk, Ab[et], aB[et][dt]); } }
    }
    bf16_t* SF = ST + ((size_t)(((0 * 2 + b) * 4 + h) * 128 + n)) * 16384; bf16_t* SB = ST + ((size_t)(((1 * 2 + b) * 4 + h) * 128 + n)) * 16384;
    typedef unsigned u32x2m __attribute__((ext_vector_type(2)));
#pragma unroll
    for (int et = 0; et < 2; ++et)
#pragma unroll
        for (int dt = 0; dt < 4; ++dt)
            { const int e = eb * 32 + et * 16 + c16, d0 = dh * 64 + dt * 16 + 4 * g; u32x2m wf_, wb_; wf_.x = pk(aF[et][dt][0], aF[et][dt][1]); wf_.y = pk(aF[et][dt][2], aF[et][dt][3]); wb_.x = pk(aB[et][dt][0], aB[et][dt][1]); wb_.y = pk(aB[et][dt][2], aB[et][dt][3]);
              *(u32x2m*)(SF + e * 128 + d0) = wf_; *(u32x2m*)(SB + e * 128 + d0) = wb_; }
    __syncthreads();
}
__device__ __forceinline__ int ret_keyk(int row) { return (((row >> 3) & 3) << 2) | (row & 3); }
__device__ __forceinline__ void ret_out_block(int cu, int tid, RLAS unsigned char* lds, bf16_t* OA, const bf16_t* RK, const bf16_t* RVT, const bf16_t* ST, const float* thf, const float* thb, const float* gain) {
    const int b = cu >> 9, h = (cu >> 7) & 3, n = cu & 127; const int lane = tid & 63, ib = tid >> 6, g = lane >> 4, c16 = lane & 15;
    const float l2f = log2_sigmoid(thf[h]), l2b = log2_sigmoid(thb[h]);
    const size_t tok0 = (size_t)b * L + n * 128;
    {
        const bf16_t* SFg = ST + ((size_t)(((0 * 2 + b) * 4 + h) * 128 + n)) * 16384; const bf16_t* SBg = ST + ((size_t)(((1 * 2 + b) * 4 + h) * 128 + n)) * 16384;
#pragma unroll 1
        for (int hf = 0; hf < 2; ++hf) {
            bf16x8 kq[2], vq[2], fq_[2], bq_[2];
#pragma unroll
            for (int i = 0; i < 2; ++i) { const int p = tid + 512 * (2 * hf + i), row = p >> 4, cc = p & 15;
                kq[i] = ld8(RK + (tok0 + row) * 512 + h * 128 + cc * 8);
                vq[i] = ld8(RVT + ((size_t)((b * 4 + h) * 128 + row)) * L + n * 128 + cc * 8);
                fq_[i] = ld8(SFg + row * 128 + cc * 8); bq_[i] = ld8(SBg + row * 128 + cc * 8); }
#pragma unroll
            for (int i = 0; i < 2; ++i) { const int p = tid + 512 * (2 * hf + i), row = p >> 4, cc = p & 15;
                *(RLAS bf16x8*)(lds + row * 256 + ((cc ^ ret_keyk(row)) << 4)) = kq[i];
                *(RLAS bf16x8*)(lds + 32768 + row * 256 + ((cc ^ (row & 15)) << 4)) = vq[i];
                *(RLAS bf16x8*)(lds + 65536 + row * 256 + ((cc ^ (row & 15)) << 4)) = fq_[i];
                *(RLAS bf16x8*)(lds + 98304 + row * 256 + ((cc ^ (row & 15)) << 4)) = bq_[i]; }
        }
    }
    const bf16_t* Qp = OA + (tok0 + ib * 16 + c16) * 512 + h * 128 + 8 * g;
    bf16x8 qf[4];
#pragma unroll
    for (int ks = 0; ks < 4; ++ks) qf[ks] = ld8(Qp + ks * 32);
    __syncthreads();
    f32x4 aI[8], aF[8], aB[8];
#pragma unroll
    for (int et = 0; et < 8; ++et) { aI[et] = (f32x4){0.f, 0.f, 0.f, 0.f}; aF[et] = aI[et]; aB[et] = aI[et]; }
    const int iq = ib * 16 + c16;
    const int slot0 = 8 * (c16 >> 2) + (c16 & 3);
#pragma unroll
    for (int kg = 0; kg < 4; ++kg) {
        f32x4 s0 = (f32x4){0.f, 0.f, 0.f, 0.f}, s1 = s0;
        const int r0 = kg * 32 + slot0, r1 = r0 + 4;
#pragma unroll
        for (int ks = 0; ks < 4; ++ks) {
            s0 = MFMA16(*(const RLAS bf16x8*)(lds + r0 * 256 + (((ks * 4 + g) ^ ret_keyk(r0)) << 4)), qf[ks], s0);
            s1 = MFMA16(*(const RLAS bf16x8*)(lds + r1 * 256 + (((ks * 4 + g) ^ ret_keyk(r1)) << 4)), qf[ks], s1); }
        float p[8];
#pragma unroll
        for (int i = 0; i < 4; ++i) {
            const int j0 = kg * 32 + 8 * g + i, j1 = j0 + 4; const int d0 = iq - j0, d1 = iq - j1;
            const float e0 = d0 >= 0 ? (float)d0 * l2f : (float)(-d0) * l2b, e1 = d1 >= 0 ? (float)d1 * l2f : (float)(-d1) * l2b;
            p[i] = s0[i] * __builtin_amdgcn_exp2f(e0); p[4 + i] = s1[i] * __builtin_amdgcn_exp2f(e1); }
        const bf16x8 pf = pack8(p[0], p[1], p[2], p[3], p[4], p[5], p[6], p[7]);
#pragma unroll
        for (int et = 0; et < 8; ++et) { const int row = et * 16 + c16; aI[et] = MFMA16(pf, *(const RLAS bf16x8*)(lds + 32768 + row * 256 + (((kg * 4 + g) ^ (row & 15)) << 4)), aI[et]); }
    }
#pragma unroll
    for (int ks = 0; ks < 4; ++ks)
#pragma unroll
        for (int et = 0; et < 8; ++et) { const int row = et * 16 + c16; const int off = row * 256 + (((ks * 4 + g) ^ (row & 15)) << 4);
            aF[et] = MFMA16(qf[ks], *(const RLAS bf16x8*)(lds + 65536 + off), aF[et]);
            aB[et] = MFMA16(qf[ks], *(const RLAS bf16x8*)(lds + 98304 + off), aB[et]); }
    float gn[8];
#pragma unroll
    for (int et = 0; et < 8; ++et) gn[et] = gain[h * 128 + et * 16 + c16];
#pragma unroll
    for (int i = 0; i < 4; ++i) {
        const int iq2 = ib * 16 + 4 * g + i; const float wq_f = __builtin_amdgcn_exp2f((float)(iq2 + 1) * l2f), wq_b = __builtin_amdgcn_exp2f((float)(128 - iq2) * l2b);
        float o[8]; float sm = 0.f;
#pragma unroll
        for (int et = 0; et < 8; ++et) { o[et] = aI[et][i] + wq_f * aF[et][i] + wq_b * aB[et][i]; sm += o[et]; }
        sm += __shfl_xor(sm, 1); sm += __shfl_xor(sm, 2); sm += __shfl_xor(sm, 4); sm += __shfl_xor(sm, 8);
        const float mean = sm * (1.0f / 128.0f); float q = 0.f;
#pragma unroll
        for (int et = 0; et < 8; ++et) { o[et] -= mean; q += o[et] * o[et]; }
        q += __shfl_xor(q, 1); q += __shfl_xor(q, 2); q += __shfl_xor(q, 4); q += __shfl_xor(q, 8);
        const float rstd = 1.0f / sqrtf(q * (1.0f / 128.0f) + 1e-5f);
        bf16_t* op = OA + (tok0 + iq2) * 512 + h * 128 + c16;
#pragma unroll
        for (int et = 0; et < 8; ++et) op[et * 16] = bf1(o[et] * rstd * gn[et]);
    }
    __syncthreads();
}
constexpr int NA_LDS_V = 73728, NA_LDS_RPB = 147456, NA_LDS_END = NA_LDS_RPB + 1920;
__device__ __forceinline__ int na_keyk(int row) { return (row & 3) | (((row >> 3) & 1) << 2); }
__device__ __forceinline__ void na_block(int cu, int tid, RLAS unsigned char* lds, bf16_t* OB, const bf16_t* NK, const bf16_t* NVT, const float* rpb) {
    const int rp2 = cu & 127, h = (cu >> 7) & 7, b = cu >> 10; const int lane = tid & 63, w = tid >> 6, g = lane >> 4, c16 = lane & 15;
    const int r0 = 2 * rp2, r = r0 + (w >> 2), g4 = w & 3;
    const int rsA = min(max(r0 - 4, 0), 248), rs = min(max(r - 4, 0), 248), dr = rs - rsA, cb = g4 < 2 ? 0 : 16;
    {
        const bf16_t* Kg = NK + ((size_t)b * L + rsA * 64) * 512 + h * 64; const bf16_t* Vg = NVT + ((size_t)((b * 8 + h) * 64)) * L + rsA * 64;
#pragma unroll 1
        for (int rd = 0; rd < 3; ++rd) {
            bf16x8 kq[3], vq[3];
#pragma unroll
            for (int i = 0; i < 3; ++i) { const int p = tid + 512 * (3 * rd + i); const int row = p >> 3, cc = p & 7; const int e = p / 72, pp = p - e * 72;
                kq[i] = ld8(Kg + (size_t)row * 512 + cc * 8); vq[i] = ld8(Vg + (size_t)e * L + pp * 8); }
#pragma unroll
            for (int i = 0; i < 3; ++i) { const int p = tid + 512 * (3 * rd + i); const int row = p >> 3, cc = p & 7; const int e = p / 72, pp = p - e * 72;
                *(RLAS bf16x8*)(lds + row * 128 + ((cc ^ na_keyk(row)) << 4)) = kq[i];
                *(RLAS bf16x8*)(lds + NA_LDS_V + e * 1152 + ((pp ^ ((e >> 1) & 7)) << 4)) = vq[i]; }
        }
        if (tid < 465) ((RLAS float*)(lds + NA_LDS_RPB))[tid] = rpb[h * 465 + tid];
    }
    const size_t qtok = (size_t)b * L + r * 64 + g4 * 16;
    const bf16_t* Qp = OB + (qtok + c16) * 512 + h * 64 + 8 * g;
    bf16x8 qf[2]; qf[0] = ld8(Qp); qf[1] = ld8(Qp + 32);
    __syncthreads();
    f32x4 S[12][2];
    {
        const int th = c16 >> 3, kkey = (c16 & 3) | (((c16 >> 2) & 1) << 2);
        unsigned kb_[2][2];
#pragma unroll
        for (int tt = 0; tt < 2; ++tt) { const int o = (8 * (c16 >> 2) + 4 * tt + (c16 & 3)) & 15; const int rowl = (dr + 4 * th) * 64 + cb + o;
            kb_[tt][0] = (unsigned)(rowl * 128 + (((0 + g) ^ kkey) << 4)); kb_[tt][1] = (unsigned)(rowl * 128 + (((4 + g) ^ kkey) << 4)); }
#pragma unroll
        for (int kk = 0; kk < 4; ++kk)
#pragma unroll
            for (int ct = 0; ct < 3; ++ct)
#pragma unroll
                for (int tt = 0; tt < 2; ++tt) { const int imm = (kk * 64 + 16 * ct) * 128;
                    f32x4 a = (f32x4){0.f, 0.f, 0.f, 0.f};
                    a = MFMA16(*(const RLAS bf16x8*)(lds + kb_[tt][0] + imm), qf[0], a);
                    a = MFMA16(*(const RLAS bf16x8*)(lds + kb_[tt][1] + imm), qf[1], a); S[3 * kk + ct][tt] = a; }
    }
    const int c = g4 * 16 + c16, cs = min(max(c - 8, 0), 48);
    const RLAS float* rp = (const RLAS float*)(lds + NA_LDS_RPB);
    float mx = -3.0e38f;
    {
        const int krow0 = rs + 4 * (g >> 1) - r + 7, kcl = cb + 8 * (g & 1) - c + 15;
#pragma unroll
        for (int kk = 0; kk < 4; ++kk)
#pragma unroll
            for (int ct = 0; ct < 3; ++ct)
#pragma unroll
                for (int tt = 0; tt < 2; ++tt)
#pragma unroll
                    for (int i = 0; i < 4; ++i) { const int dc = kcl + 16 * ct + 4 * tt + i;
                        const int kc = dc + c - 15; const bool valid = (kc >= cs) && (kc < cs + 16);
                        const int ci = min(max(dc, 0), 30);
                        const float sv = valid ? S[3 * kk + ct][tt][i] + rp[(krow0 + kk) * 31 + ci] : -3.0e38f; S[3 * kk + ct][tt][i] = sv; mx = fmaxf(mx, sv); }
    }
    mx = fmaxf(mx, __shfl_xor(mx, 16)); mx = fmaxf(mx, __shfl_xor(mx, 32));
    float sum = 0.f;
#pragma unroll
    for (int gi = 0; gi < 12; ++gi)
#pragma unroll
        for (int tt = 0; tt < 2; ++tt)
#pragma unroll
            for (int i = 0; i < 4; ++i) { const float pv = __builtin_amdgcn_exp2f((S[gi][tt][i] - mx) * 1.4426950408889634f); S[gi][tt][i] = pv; sum += pv; }
    sum += __shfl_xor(sum, 16); sum += __shfl_xor(sum, 32);
    f32x4 O[4];
#pragma unroll
    for (int et = 0; et < 4; ++et) O[et] = (f32x4){0.f, 0.f, 0.f, 0.f};
    {
        const int vkey = (c16 >> 1) & 7; unsigned vb_[3];
#pragma unroll
        for (int ct = 0; ct < 3; ++ct) { const int low3 = (cb >> 3) + 2 * ct + (g & 1); vb_[ct] = (unsigned)(NA_LDS_V + c16 * 1152 + (((dr + 4 * (g >> 1)) * 8 + (low3 ^ vkey)) << 4)); }
#pragma unroll
        for (int kk = 0; kk < 4; ++kk)
#pragma unroll
            for (int ct = 0; ct < 3; ++ct) { const int gi = 3 * kk + ct;
                const bf16x8 pf = pack8(S[gi][0][0], S[gi][0][1], S[gi][0][2], S[gi][0][3], S[gi][1][0], S[gi][1][1], S[gi][1][2], S[gi][1][3]);
#pragma unroll
                for (int et = 0; et < 4; ++et) O[et] = MFMA16(pf, *(const RLAS bf16x8*)(lds + vb_[ct] + kk * 128 + et * 18432), O[et]); }
    }
    const float rinv = 1.0f / sum;
#pragma unroll
    for (int i = 0; i < 4; ++i) { const float ri = __shfl(rinv, 4 * g + i); bf16_t* op = OB + (qtok + 4 * g + i) * 512 + h * 64 + c16;
#pragma unroll
        for (int et = 0; et < 4; ++et) op[et * 16] = bf1(O[et][i] * ri); }
    __syncthreads();
}
#undef MFMA16
}

namespace cg = cooperative_groups;
#define LAS __attribute__((address_space(3)))
#define GAS __attribute__((address_space(1)))
typedef unsigned short bf16;
typedef unsigned v4u __attribute__((ext_vector_type(4)));
typedef float f32x4 __attribute__((ext_vector_type(4)));
constexpr int NWAVES = 8;
constexpr int BATCH = 2, SEQ = 16384, T = BATCH * SEQ, D = 1024, DEPTH = 2, DIN = 8448, N1 = 3840, N3 = 4608;
constexpr float LN_EPS = 1e-5f;
constexpr size_t SZ_WL = (size_t)(DIN + 1536 + 1024) * 1024 * 2;
constexpr size_t WO_IN = 0, WO_A = (size_t)DIN * 1024, WO_B = WO_A + 1024 * 512, WO_C = WO_B + 1024 * 512, WO_OUT = WO_C + 1024 * 512;
constexpr size_t SZ_H = (size_t)T * 512 * 2;
constexpr size_t WS_W = 0, WS_XB = WS_W + DEPTH * SZ_WL, WS_OA = WS_XB + (size_t)T * D * 2, WS_OB = WS_OA + SZ_H, WS_OC = WS_OB + SZ_H,
                 WS_RK = WS_OC + SZ_H, WS_RKT = WS_RK + SZ_H, WS_RVT = WS_RKT + SZ_H, WS_NK = WS_RVT + SZ_H, WS_NVT = WS_NK + SZ_H,
                 WS_CK = WS_NVT + SZ_H, WS_CV = WS_CK + (size_t)T * 128 * 2, WS_ST = WS_CV + (size_t)T * 128 * 2, WS_END = WS_ST + (size_t)2 * 2 * 4 * 128 * 16384 * 4;
constexpr size_t WS_BAR = WS_END;
constexpr size_t WS_ZERO_BYTES = 256 + 2 * 128 * 256, WS_XCH = WS_BAR + WS_ZERO_BYTES, WS_TOP = WS_XCH + (size_t)32768 * 4 * 8;
constexpr size_t WS_SG = WS_RK, WS_Y = WS_SG + (size_t)T * 3072 * 2;
static_assert(WS_TOP <= (size_t)512 * 1024 * 1024 && WS_END % 256 == 0 && WS_Y + (size_t)T * 1024 * 2 <= WS_END && WS_XB % 256 == 0, "d_ws map");
constexpr int LDS_BYTES = 151552;
static_assert(mix::NA_LDS_END <= LDS_BYTES, "LDS map");

__device__ __forceinline__ int in_src_col(int n) {
    if (n < N1) { const int pn = n >> 8, w = n & 255, bj = w >> 7, wcc = (w >> 5) & 3;
        if (pn < 4) { const int base = (pn < 2) ? 0 : 512, head = 2 * (pn & 1) + (wcc >> 1); return base + head * 128 + bj * 64 + 32 * (wcc & 1); }
        if (pn < 6) return 1024 + 256 * (pn - 4) + w;
        if (pn < 8) return 3072 + 256 * (pn - 6) + w;
        if (pn < 10) return 2048 + 256 * (pn - 8) + w;
        if (pn < 12) return 2560 + 256 * (pn - 10) + w;
        if (pn < 14) { const int head = 4 * (pn - 12) + wcc; return 4096 + head * 64 + bj * 32; }
        if (wcc < 2) return 4608 + wcc * 64 + bj * 32;
        return 4736 + 64 * bj + 32 * (wcc - 2);
    }
    const int c = n - N1;
    if (c < 512) return 1536 + c; if (c < 1024) return 3584 + (c - 512); if (c < 1536) return 4864 + (c - 1024); return 5376 + (c - 1536);
}
__device__ __forceinline__ unsigned f2bf(float f) { unsigned u = __builtin_bit_cast(unsigned, f); return (u + 0x7fffu + ((u >> 16) & 1u)) >> 16; }
__device__ __forceinline__ unsigned pk2(float lo, float hi) { return f2bf(lo) | (f2bf(hi) << 16); }
#define LDS_WAIT() asm volatile("s_waitcnt lgkmcnt(0)" ::: "memory")
__device__ __forceinline__ void transpose_item(const float* W, int K, int N, bf16* WT, bool smap, LAS float* scr, int item, int lane) {
    const int nblk = N / 32, kb = item / nblk, nb = item % nblk, k0 = 64 * kb, n0 = 32 * nb; const int sc0 = smap ? in_src_col(n0) : n0;
#pragma unroll 8
    for (int i = 0; i < 32; ++i) { const int kk = 2 * i + (lane >> 5); scr[kk * 33 + (lane & 31)] = W[(size_t)(k0 + kk) * N + sc0 + (lane & 31)]; }
    LDS_WAIT(); asm volatile("" ::: "memory");
    const int c = lane & 7;
#pragma unroll
    for (int j = 0; j < 4; ++j) { const int n = (lane >> 3) + 8 * j; const LAS float* s = scr + (8 * c) * 33 + n;
        v4u o; o.x = pk2(s[0 * 33], s[1 * 33]); o.y = pk2(s[2 * 33], s[3 * 33]); o.z = pk2(s[4 * 33], s[5 * 33]); o.w = pk2(s[6 * 33], s[7 * 33]);
        *(v4u*)(WT + (size_t)(n0 + n) * K + k0 + 8 * c) = o; }
    LDS_WAIT(); asm volatile("" ::: "memory");
}
__device__ __forceinline__ float wave_sum(float v) {
#pragma unroll
    for (int o = 1; o < 64; o <<= 1) v += __shfl_xor(v, o);
    return v;
}

struct Args { const float* in[14]; float* out; unsigned char* ws; };
typedef const __attribute__((address_space(4))) unsigned long long* kargp_t;
__device__ __forceinline__ kargp_t kargs() { kargp_t p = (kargp_t)__builtin_amdgcn_kernarg_segment_ptr(); asm volatile("" : "+s"(p)); return p; }
#define ARG_IN(i) ((const float*)(const GAS float*)kargs()[i])
#define ARG_OUT ((float*)(GAS float*)kargs()[14])
#define ARG_WS ((unsigned char*)(GAS unsigned char*)kargs()[15])
#define BF(w, off) ((bf16*)((w) + (off)))
__global__ void __launch_bounds__(NWAVES * 64, 2) fwd(Args args) {
    extern __shared__ __attribute__((aligned(16))) unsigned char lds[];
    cg::grid_group grid = cg::this_grid();
#define PHASE_IDS() int tid = threadIdx.x; asm volatile("" : "+v"(tid)); const int lane = tid & 63, wave = __builtin_amdgcn_readfirstlane(tid >> 6); \
    int G = gridDim.x; asm volatile("" : "+s"(G)); int bx = blockIdx.x; asm volatile("" : "+s"(bx)); \
    const int vcu = (G % 8 == 0) ? (bx % 8) * (G / 8) + bx / 8 : bx; const int gw = vcu * NWAVES + wave, NGW = G * NWAVES; (void)lane; (void)gw; (void)NGW; (void)vcu
    LAS unsigned char* ldsl = (LAS unsigned char*)lds;
    int nbar = 0;
    grid.sync();
#define GRID_SYNC() do { asm volatile("s_waitcnt vmcnt(0) lgkmcnt(0)" ::: "memory"); __syncthreads(); ++nbar; \
        if (threadIdx.x == 0) { unsigned* bw = (unsigned*)(ARG_WS + WS_BAR); __builtin_amdgcn_fence(__ATOMIC_RELEASE, "agent"); asm volatile("s_waitcnt vmcnt(0)" ::: "memory"); \
            __hip_atomic_fetch_add(bw, 1u, __ATOMIC_RELAXED, __HIP_MEMORY_SCOPE_AGENT); const unsigned want = (unsigned)nbar * gridDim.x; \
            while (__hip_atomic_load(bw, __ATOMIC_RELAXED, __HIP_MEMORY_SCOPE_AGENT) < want) __builtin_amdgcn_s_sleep(1); \
            __builtin_amdgcn_fence(__ATOMIC_ACQUIRE, "agent"); asm volatile("s_waitcnt vmcnt(0)" ::: "memory"); } \
        __syncthreads(); } while (0)
    {
        PHASE_IDS(); unsigned char* w = ARG_WS;
        LAS float* scr = (LAS float*)(ldsl + wave * 16384);
        constexpr int I_IN = (1024 / 64) * (DIN / 32), I_BR = (512 / 64) * (1024 / 32), I_OUT = (1024 / 64) * (1024 / 32), I_L = I_IN + 3 * I_BR + I_OUT;
        for (int it = gw; it < DEPTH * I_L; it += NGW) {
            const int l = it / I_L; int r = it % I_L; bf16* WL = BF(w, WS_W + (size_t)l * SZ_WL);
            if (r < I_IN) { transpose_item(ARG_IN(1) + (size_t)l * 1024 * DIN, 1024, DIN, WL + WO_IN, true, scr, r, lane); continue; } r -= I_IN;
            if (r < I_BR) { transpose_item(ARG_IN(8) + (size_t)l * 512 * 1024, 512, 1024, WL + WO_A, false, scr, r, lane); continue; } r -= I_BR;
            if (r < I_BR) { transpose_item(ARG_IN(9) + (size_t)l * 512 * 1024, 512, 1024, WL + WO_B, false, scr, r, lane); continue; } r -= I_BR;
            if (r < I_BR) { transpose_item(ARG_IN(10) + (size_t)l * 512 * 1024, 512, 1024, WL + WO_C, false, scr, r, lane); continue; } r -= I_BR;
            transpose_item(ARG_IN(11) + (size_t)l * 1024 * 1024, 1024, 1024, WL + WO_OUT, false, scr, r, lane);
        }
        const float* x_in = ARG_IN(0); bf16* XB = BF(w, WS_XB);
        for (int m0 = gw; m0 < T; m0 += 4 * NGW) {
            f32x4 v[4][4];
#pragma unroll
            for (int q = 0; q < 4; ++q) { const f32x4* xr = (const f32x4*)(x_in + (size_t)(m0 + q * NGW) * D) + lane;
#pragma unroll
                for (int j = 0; j < 4; ++j) v[q][j] = xr[64 * j]; }
#pragma unroll
            for (int q = 0; q < 4; ++q) { unsigned long long* o8 = (unsigned long long*)(XB + (size_t)(m0 + q * NGW) * D) + lane;
#pragma unroll
                for (int j = 0; j < 4; ++j) o8[64 * j] = (unsigned long long)pk2(v[q][j][0], v[q][j][1]) | ((unsigned long long)pk2(v[q][j][2], v[q][j][3]) << 32); } }
    }
    GRID_SYNC();

#pragma unroll 1
    for (int l = 0; l < DEPTH; ++l) {
        { PHASE_IDS(); unsigned char* w = ARG_WS; const bf16* WL = BF(w, WS_W + (size_t)l * SZ_WL);
          pg8::Gemm g{BF(w, WS_XB), WL + WO_IN, T, N1, D}; pg8::StaticOrder S; S.init(T, N1, G, bx);
          pg8::EpiIn E{BF(w, WS_OA), BF(w, WS_OB), BF(w, WS_OC), BF(w, WS_RK), BF(w, WS_RKT), BF(w, WS_RVT), BF(w, WS_NK), BF(w, WS_NVT), BF(w, WS_CK), BF(w, WS_CV), ARG_IN(6) + l * 64, ARG_IN(7) + l * 64};
          pg8::gemm_phase<pg8::EpiIn, pg8::StaticOrder, true, true>(ldsl, g, S, E);
          }
        GRID_SYNC();
        { PHASE_IDS(); unsigned char* w = ARG_WS; const float* thf = ARG_IN(2) + l * 4; const float* thb = ARG_IN(3) + l * 4;
          for (int cu = vcu; cu < 1024; cu += G) mix::ret_kv_block(cu, tid, ldsl, BF(w, WS_RKT), BF(w, WS_RVT), BF(w, WS_ST), thf, thb);
          }
        GRID_SYNC();
        { PHASE_IDS(); unsigned char* w = ARG_WS; const float* thf = ARG_IN(2) + l * 4; const float* thb = ARG_IN(3) + l * 4; unsigned* ST2 = (unsigned*)(w + WS_ST);
          for (int e = bx * (NWAVES * 64) + tid; e < 16 * 8192; e += G * NWAVES * 64) {
            const int stream = e >> 13, ed2 = e & 8191, dir = stream >> 3, h = stream & 3;
            const float cdec = __builtin_amdgcn_exp2f(128.0f * mix::log2_sigmoid(dir ? thb[h] : thf[h]));
            unsigned* base = ST2 + (size_t)stream * 128 * 8192 + ed2; float s0 = 0.f, s1 = 0.f;
#pragma unroll 1
            for (int nb = 0; nb < 128; nb += 32) {
                unsigned kv[32];
#pragma unroll
                for (int j = 0; j < 32; ++j) { const int n = dir ? 127 - (nb + j) : nb + j; kv[j] = base[(size_t)n * 8192]; }
#pragma unroll
                for (int j = 0; j < 32; ++j) { const int n = dir ? 127 - (nb + j) : nb + j; base[(size_t)n * 8192] = pk2(s0, s1); s0 = cdec * s0 + __uint_as_float(kv[j] << 16); s1 = cdec * s1 + __uint_as_float(kv[j] & 0xffff0000u); }
            }
          } }
        GRID_SYNC();
        { PHASE_IDS(); unsigned char* w = ARG_WS;
          const attn_body::AttnTensors AT{(const attn_body::bf16*)BF(w, WS_OC), (const attn_body::bf16*)BF(w, WS_CK), (const attn_body::bf16*)BF(w, WS_CV), (attn_body::bf16*)BF(w, WS_OC)};
          float gq = fabsf(ARG_IN(6)[l * 64 + lane]), gk = fabsf(ARG_IN(7)[l * 64 + lane]);
#pragma unroll
          for (int o = 1; o < 64; o <<= 1) { gq = fmaxf(gq, __shfl_xor(gq, o)); gk = fmaxf(gk, __shfl_xor(gk, o)); }
          const float Mref = fminf(8.0f * 1.4426950408889634f * gq * gk, 100.0f);
          attn_body::attn_phase<8>((char*)lds, AT, vcu, G, Mref); }
        { PHASE_IDS(); unsigned char* w = ARG_WS; const float* rpb = ARG_IN(5) + l * 8 * 15 * 31;
          for (int cu = vcu; cu < 2048; cu += G) mix::na_block(cu, tid, ldsl, BF(w, WS_OB), BF(w, WS_NK), BF(w, WS_NVT), rpb);
          }
        { PHASE_IDS(); unsigned char* w = ARG_WS; const float* thf = ARG_IN(2) + l * 4; const float* thb = ARG_IN(3) + l * 4; const float* gain = ARG_IN(4) + l * 512;
          for (int cu = vcu; cu < 1024; cu += G) mix::ret_out_block(cu, tid, ldsl, BF(w, WS_OA), BF(w, WS_RK), BF(w, WS_RVT), BF(w, WS_ST), thf, thb, gain);
          }
        GRID_SYNC();
        { PHASE_IDS(); unsigned char* w = ARG_WS; const bf16* WL = BF(w, WS_W + (size_t)l * SZ_WL);
          pg8::Gemm g{BF(w, WS_XB), WL + WO_IN + (size_t)N1 * 1024, T, 1536, D}; pg8::StaticOrder S; S.init(T, 1536, G, bx);
          pg8::EpiZ E{BF(w, WS_OA)};
          pg8::gemm_phase<pg8::EpiZ, pg8::StaticOrder, true, true>(ldsl, g, S, E); }
        { PHASE_IDS(); unsigned char* w = ARG_WS; const bf16* WL = BF(w, WS_W + (size_t)l * SZ_WL);
          pg8::Gemm g{BF(w, WS_XB), WL + WO_IN + (size_t)(N1 + 1536) * 1024, T, 3072, D}; pg8::StaticOrder S; S.init(T, 3072, G, bx);
          pg8::EpiG E{BF(w, WS_SG)};
          pg8::gemm_phase<pg8::EpiG, pg8::StaticOrder, true, true>(ldsl, g, S, E);
          }
        GRID_SYNC();
        {
            PHASE_IDS(); unsigned char* w = ARG_WS; const bf16* WL = BF(w, WS_W + (size_t)l * SZ_WL);
            pg8::Gemm g{BF(w, WS_OA), WL + WO_A, 3 * T, 3 * D, 512}; pg8::BranchOrder S{G, bx};
            pg8::EpiBr E{BF(w, WS_SG), BF(w, WS_Y)};
            pg8::gemm_phase<pg8::EpiBr, pg8::BranchOrder, true, true>(ldsl, g, S, E);
        }
        GRID_SYNC();
        { PHASE_IDS(); unsigned char* w = ARG_WS; const bf16* WL = BF(w, WS_W + (size_t)l * SZ_WL); float* out = ARG_OUT; const float* res = (l == 0) ? ARG_IN(0) : (const float*)out;

          pg8::Gemm g{BF(w, WS_Y), WL + WO_OUT, T, D, D};
          pg8::StaticOrder S; S.init(T, D, G, bx);
          pg8::EpiOutLn E{res, out, BF(w, WS_XB), ARG_IN(12) + l * 1024, ARG_IN(13) + l * 1024, (unsigned long long*)(w + WS_XCH), (unsigned*)(w + WS_BAR) + 64 + l * 128 * 64, 1.4142135623730951f, (l + 1 < DEPTH) ? 1 : 0};
          pg8::gemm_phase<pg8::EpiOutLn, pg8::StaticOrder, true, true>(ldsl, g, S, E); }
        if (l + 1 < DEPTH) GRID_SYNC();
    }
}

extern "C" void kernel_launch(void* const* d_in, const int* in_sizes, int n_in, void* d_out, int out_size, void* d_ws, size_t ws_size, hipStream_t stream) {
    static int grid = 0;
    if (grid == 0) {
        if (n_in != 14 || in_sizes[0] != T * D || out_size != T * D || ws_size < WS_TOP) { fprintf(stderr, "kernel_launch: unexpected shapes (n_in %d, in0 %d, out %d, ws %zu < %zu)\n", n_in, n_in > 0 ? in_sizes[0] : -1, out_size, ws_size, (size_t)WS_END); grid = -1; return; }
        int dev = 0, cus = 0, per_cu = 0;
        hipGetDevice(&dev); hipDeviceGetAttribute(&cus, hipDeviceAttributeMultiprocessorCount, dev);
        if (hipFuncSetAttribute((const void*)fwd, hipFuncAttributeMaxDynamicSharedMemorySize, LDS_BYTES) != hipSuccess) { fprintf(stderr, "kernel_launch: hipFuncSetAttribute failed\n"); grid = -1; return; }
        if (hipOccupancyMaxActiveBlocksPerMultiprocessor(&per_cu, (const void*)fwd, NWAVES * 64, LDS_BYTES) != hipSuccess || per_cu < 1) { fprintf(stderr, "kernel_launch: occupancy query says %d\n", per_cu); per_cu = 1; }
        (void)hipGetLastError();
        grid = cus;
        if (grid != 256) { fprintf(stderr, "kernel_launch: built for 256 CUs (the fused LayerNorm epilogue needs the four column-tile owners of a row panel in the same round); found %d: nothing launched\n", cus); grid = -1; return; }
    }
    if (grid < 0) return;
    if (hipMemsetAsync((char*)d_ws + WS_BAR, 0, WS_ZERO_BYTES, stream) != hipSuccess) { fprintf(stderr, "kernel_launch: hipMemsetAsync failed\n"); return; }
    Args a{};
    for (int i = 0; i < 14; ++i) a.in[i] = (const float*)d_in[i];
    a.out = (float*)d_out; a.ws = (unsigned char*)d_ws;
    void* kargs[] = {&a};
    hipError_t e = hipLaunchCooperativeKernel((const void*)fwd, dim3(grid), dim3(NWAVES * 64), kargs, LDS_BYTES, stream);
    if (e != hipSuccess) fprintf(stderr, "kernel_launch: cooperative launch failed: %s (grid %d)\n", hipGetErrorString(e), grid);
}
```

```cpp
#include <hip/hip_runtime.h>
#include <hip/hip_cooperative_groups.h>
#include <cstdio>
#include <cstdint>
namespace pg8 {
#define PG8_LAS __attribute__((address_space(3)))
typedef unsigned short bf16_t;
typedef short bf16x8 __attribute__((ext_vector_type(8)));
typedef float f32x4 __attribute__((ext_vector_type(4)));
typedef unsigned u32x4 __attribute__((ext_vector_type(4)));
constexpr int BM = 256, BK = 64, HALF = 128, HTB = HALF * BK * 2  , STAGE_BYTES = 8 * HTB, NXCD = 8, WGM = 8;

__host__ __device__ __forceinline__ int lds_byte(int r, int c) { const int st = (r >> 4) * 2 + (c >> 5), rr = r & 15, cc = c & 31, ob = rr * 64 + cc * 2; return st * 1024 + (ob ^ (((ob >> 9) & 1) << 5)); }
__host__ __device__ __forceinline__ void stage_rc(int b, int& R, int& C) { const int st = b / 1024, sb = b % 1024, swz = sb ^ (((sb >> 9) & 1) << 5); R = (st >> 1) * 16 + swz / 64; C = (st & 1) * 32 + (swz % 64) / 2; }
__host__ __device__ __forceinline__ int perm32(int rho) { const int n = rho >> 4, i = rho & 15; return 8 * (i >> 2) + 4 * n + (i & 3); }

struct Unit { int pm, pn; };
struct Gemm { const bf16_t* A; const bf16_t* Bt; int M, N, K; };

struct StaticOrder {
    int nM, nN, nwg, G, c;
    __host__ __device__ void init(int M, int N, int G_, int c_) { nM = M / BM; nN = N / BM; nwg = nM * nN; G = G_; c = c_; }
    __host__ __device__ bool next(int i, Unit& u) const {
        const long L = (long)i * G + c; if (L >= nwg) return false;
        int wgid = (int)L; { const int q = nwg / NXCD, r = nwg % NXCD, xcd = wgid % NXCD, off = wgid / NXCD; wgid = (xcd < r ? xcd * (q + 1) : r * (q + 1) + (xcd - r) * q) + off; }
        const int nig = WGM * nN, gid = wgid / nig, fm = gid * WGM, gsz = (nM - fm) < WGM ? (nM - fm) : WGM;
        u.pm = fm + ((wgid % nig) % gsz); u.pn = (wgid % nig) / gsz; return true;
    }
    __device__ __forceinline__ void a_ready(const Unit&) const {}
    __device__ __forceinline__ void done(const Unit&) const {}
};

typedef float f32x2c_t __attribute__((ext_vector_type(2))); typedef __bf16 bf16x2c_t __attribute__((ext_vector_type(2)));
__device__ __forceinline__ unsigned cvt_pk_bf16(float lo, float hi) { f32x2c_t v = {lo, hi}; bf16x2c_t b = __builtin_convertvector(v, bf16x2c_t); return __builtin_bit_cast(unsigned, b); }
typedef float f32x2 __attribute__((ext_vector_type(2)));
typedef unsigned u32x2 __attribute__((ext_vector_type(2)));
constexpr int SEQL = 16384;
__device__ __forceinline__ float bf_lo(unsigned w) { return __uint_as_float(w << 16); }
__device__ __forceinline__ float bf_hi(unsigned w) { return __uint_as_float(w & 0xffff0000u); }
__device__ __forceinline__ bf16_t f2bf1(float f) { return (bf16_t)(cvt_pk_bf16(f, 0.f) & 0xffffu); }
__device__ __forceinline__ void sincos_rad(float ang, float& s, float& c) {
    double rev = (double)ang * 0.15915494309189535; rev -= __builtin_rint(rev);
    const float f = (float)rev; s = __builtin_amdgcn_sinf(f); c = __builtin_amdgcn_cosf(f);
}
typedef unsigned u32x4e __attribute__((ext_vector_type(4)));
__device__ __forceinline__ u32x4e pack8v(const float* a) { u32x4e w; w.x = cvt_pk_bf16(a[0], a[1]); w.y = cvt_pk_bf16(a[2], a[3]); w.z = cvt_pk_bf16(a[4], a[5]); w.w = cvt_pk_bf16(a[6], a[7]); return w; }
__device__ __forceinline__ void st_t4(bf16_t* t, unsigned a, unsigned b2) { t[0] = (bf16_t)(a & 0xffffu); t[(size_t)SEQL] = (bf16_t)(a >> 16); t[(size_t)2 * SEQL] = (bf16_t)(b2 & 0xffffu); t[(size_t)3 * SEQL] = (bf16_t)(b2 >> 16); }
struct EpiIn {
    static constexpr bool PERM = true, AFTER_DRAIN = false;
    bf16_t *OA, *OB, *OC, *RK, *RKT, *RVT, *NK, *NVT, *CK, *CV; const float *qn, *kn;
    __device__ __forceinline__ void operator()(const f32x4 (&acc)[2][2][4][2], const Unit& u, int wr, int wc, int fr, int fq) const {
        const int pn = u.pn;
        const int rowb = u.pm * BM + wr * 64 + fr;
        const int bt = u.pm >> 6;
        const int posb = (u.pm & 63) * BM + wr * 64 + fr;
        if (pn < 4) {
            const bool isq = pn < 2; const float sc = isq ? 0.08838834764831845f : 1.0f;
            const int head = 2 * (pn & 1) + (wc >> 1); const int i0 = 32 * (wc & 1) + 8 * fq;
            bf16_t* dst = isq ? OA : RK;
            float inv[8];
#pragma unroll
            for (int q = 0; q < 8; ++q) inv[q] = __builtin_amdgcn_exp2f(-(float)(i0 + q) * 0.2109160695166579f);
#pragma unroll
            for (int ai = 0; ai < 2; ++ai)
#pragma unroll
                for (int m = 0; m < 4; ++m) {
                    const int row = rowb + ai * HALF + m * 16; int pos = posb + ai * HALF + m * 16; asm volatile("" : "+v"(pos));
                    float o1[8], o2[8];
#pragma unroll
                    for (int n = 0; n < 2; ++n)
#pragma unroll
                        for (int j = 0; j < 4; ++j) { float s, c; sincos_rad((float)pos * inv[4 * n + j], s, c);
                            const float x1 = acc[ai][0][m][n][j], x2 = acc[ai][1][m][n][j];
                            o1[4 * n + j] = (x1 * c - x2 * s) * sc; o2[4 * n + j] = (x2 * c + x1 * s) * sc; }
                    const u32x4e w1 = pack8v(o1), w2 = pack8v(o2);
                    bf16_t* p = dst + (size_t)row * 512 + head * 128 + i0;
                    *(u32x4e*)p = w1; *(u32x4e*)(p + 64) = w2;
                    if (!isq) {
                        bf16_t* t = RKT + ((size_t)((bt * 4 + head) * 128 + i0)) * SEQL + pos;
                        st_t4(t, w1.x, w1.y); st_t4(t + (size_t)4 * SEQL, w1.z, w1.w); st_t4(t + (size_t)64 * SEQL, w2.x, w2.y); st_t4(t + (size_t)68 * SEQL, w2.z, w2.w);
                    }
                    __builtin_amdgcn_sched_barrier(0);
                }
        } else if (pn < 8) {
            bf16_t* XT = (pn < 6) ? RVT : NVT; const int cb = 256 * ((pn < 6) ? (pn - 4) : (pn - 6)) + wc * 32 + 8 * fq;
#pragma unroll
            for (int ai = 0; ai < 2; ++ai)
#pragma unroll
                for (int m = 0; m < 4; ++m) { const int pos = posb + ai * HALF + m * 16;
#pragma unroll
                    for (int bj = 0; bj < 2; ++bj)
#pragma unroll
                        for (int n = 0; n < 2; ++n) { bf16_t* t = XT + ((size_t)(bt * 512 + cb + bj * HALF + 4 * n)) * SEQL + pos; const f32x4 v = acc[ai][bj][m][n];
                            st_t4(t, cvt_pk_bf16(v[0], v[1]), cvt_pk_bf16(v[2], v[3])); } }
        } else if (pn < 12) {
            const bool isq = pn < 10; const float sc = isq ? 0.125f : 1.0f; bf16_t* dst = isq ? OB : NK;
            const int cb = 256 * (isq ? (pn - 8) : (pn - 10)) + wc * 32 + 8 * fq;
#pragma unroll
            for (int ai = 0; ai < 2; ++ai)
#pragma unroll
                for (int m = 0; m < 4; ++m) { bf16_t* rp = dst + (size_t)(rowb + ai * HALF + m * 16) * 512 + cb;
#pragma unroll
                    for (int bj = 0; bj < 2; ++bj) { const f32x4 v0 = acc[ai][bj][m][0] * sc, v1 = acc[ai][bj][m][1] * sc; u32x4e w; w.x = cvt_pk_bf16(v0[0], v0[1]); w.y = cvt_pk_bf16(v0[2], v0[3]); w.z = cvt_pk_bf16(v1[0], v1[1]); w.w = cvt_pk_bf16(v1[2], v1[3]);
                        *(u32x4e*)(rp + bj * HALF) = w; } }
        } else if (pn < 14 || wc < 2) {
            const bool isq = pn < 14; const float sc = isq ? 0.18033688011112042f : 1.0f;
            const int head = isq ? 4 * (pn - 12) + wc : wc; const int pitch = isq ? 512 : 128;
            bf16_t* dst = isq ? OC : CK; const float* g = isq ? qn : kn;
            float g1[8], g2[8], inv[8];
#pragma unroll
            for (int q = 0; q < 8; ++q) { inv[q] = __builtin_amdgcn_exp2f(-(float)(8 * (fq & 1) + q) * 0.8304820237218406f); g1[q] = g[8 * fq + q]; g2[q] = g[32 + 8 * fq + q]; }
#pragma unroll
            for (int ai = 0; ai < 2; ++ai)
#pragma unroll
                for (int m = 0; m < 4; ++m) {
                    const int row = rowb + ai * HALF + m * 16; int pos = posb + ai * HALF + m * 16; asm volatile("" : "+v"(pos));
                    float ss = 0.f;
#pragma unroll
                    for (int bj = 0; bj < 2; ++bj)
#pragma unroll
                        for (int n = 0; n < 2; ++n) { const f32x4 v = acc[ai][bj][m][n]; ss += (v[0] * v[0] + v[1] * v[1]) + (v[2] * v[2] + v[3] * v[3]); }
                    ss += __shfl_xor(ss, 16); ss += __shfl_xor(ss, 32);
                    const float rms = 1.0f / sqrtf(ss * (1.0f / 64.0f) + 1e-6f);
                    const float pa = (fq < 2) ? (float)(pos >> 6) : (float)(pos & 63);
                    float o1[8], o2[8];
#pragma unroll
                    for (int n = 0; n < 2; ++n)
#pragma unroll
                        for (int j = 0; j < 4; ++j) { const int q = 4 * n + j; float s, c; sincos_rad(pa * inv[q], s, c);
                            const float x1 = acc[ai][0][m][n][j] * rms * g1[q], x2 = acc[ai][1][m][n][j] * rms * g2[q];
                            o1[q] = (x1 * c - x2 * s) * sc; o2[q] = (x2 * c + x1 * s) * sc; }
                    bf16_t* p = dst + (size_t)row * pitch + head * 64 + 8 * fq;
                    *(u32x4e*)p = pack8v(o1); *(u32x4e*)(p + 32) = pack8v(o2);
                    __builtin_amdgcn_sched_barrier(0);
                }
        } else {
#pragma unroll
            for (int ai = 0; ai < 2; ++ai)
#pragma unroll
                for (int m = 0; m < 4; ++m) { bf16_t* rp = CV + (size_t)(rowb + ai * HALF + m * 16) * 128 + 32 * (wc - 2) + 8 * fq;
#pragma unroll
                    for (int bj = 0; bj < 2; ++bj) { const f32x4 v0 = acc[ai][bj][m][0], v1 = acc[ai][bj][m][1]; u32x4e w; w.x = cvt_pk_bf16(v0[0], v0[1]); w.y = cvt_pk_bf16(v0[2], v0[3]); w.z = cvt_pk_bf16(v1[0], v1[1]); w.w = cvt_pk_bf16(v1[2], v1[3]);
                        *(u32x4e*)(rp + bj * 64) = w; } }
        }
    }
};
__device__ __forceinline__ float sigm(float z) { return __builtin_amdgcn_rcpf(1.0f + __builtin_amdgcn_exp2f(-1.4426950408889634f * z)); }
struct EpiZ {
    static constexpr bool PERM = true, AFTER_DRAIN = false;
    bf16_t* OA;
    __device__ __forceinline__ void operator()(const f32x4 (&acc)[2][2][4][2], const Unit& u, int wr, int wc, int fr, int fq) const {
        const int pn = u.pn; const int rowb = u.pm * BM + wr * 64 + fr;
        bf16_t* O = OA + (size_t)(pn >> 1) * ((size_t)32768 * 512); const int cb = 256 * (pn & 1) + wc * 32 + 8 * fq;
#pragma unroll
        for (int ai = 0; ai < 2; ++ai) {
            u32x4e o[4][2];
#pragma unroll
            for (int m = 0; m < 4; ++m)
#pragma unroll
                for (int bj = 0; bj < 2; ++bj) o[m][bj] = *(const u32x4e*)(O + (size_t)(rowb + ai * HALF + m * 16) * 512 + cb + bj * HALF);
#pragma unroll
            for (int m = 0; m < 4; ++m)
#pragma unroll
                for (int bj = 0; bj < 2; ++bj) { const f32x4 z0 = acc[ai][bj][m][0], z1 = acc[ai][bj][m][1]; const u32x4e ov = o[m][bj];
                    u32x4e w; w.x = cvt_pk_bf16(bf_lo(ov.x) * z0[0] * sigm(z0[0]), bf_hi(ov.x) * z0[1] * sigm(z0[1])); w.y = cvt_pk_bf16(bf_lo(ov.y) * z0[2] * sigm(z0[2]), bf_hi(ov.y) * z0[3] * sigm(z0[3]));
                    w.z = cvt_pk_bf16(bf_lo(ov.z) * z1[0] * sigm(z1[0]), bf_hi(ov.z) * z1[1] * sigm(z1[1])); w.w = cvt_pk_bf16(bf_lo(ov.w) * z1[2] * sigm(z1[2]), bf_hi(ov.w) * z1[3] * sigm(z1[3]));
                    *(u32x4e*)(O + (size_t)(rowb + ai * HALF + m * 16) * 512 + cb + bj * HALF) = w; }
            __builtin_amdgcn_sched_barrier(0);
        }
    }
};
struct EpiG {
    static constexpr bool PERM = true, AFTER_DRAIN = false;
    bf16_t* SG;
    __device__ __forceinline__ void operator()(const f32x4 (&acc)[2][2][4][2], const Unit& u, int wr, int wc, int fr, int fq) const {
        const int rowb = u.pm * BM + wr * 64 + fr; const int cb = 256 * u.pn + wc * 32 + 8 * fq;
#pragma unroll
        for (int ai = 0; ai < 2; ++ai)
#pragma unroll
            for (int m = 0; m < 4; ++m) { bf16_t* rp = SG + (size_t)(rowb + ai * HALF + m * 16) * 3072 + cb;
#pragma unroll
                for (int bj = 0; bj < 2; ++bj) { const f32x4 z0 = acc[ai][bj][m][0], z1 = acc[ai][bj][m][1];
                    u32x4e w; w.x = cvt_pk_bf16(sigm(z0[0]), sigm(z0[1])); w.y = cvt_pk_bf16(sigm(z0[2]), sigm(z0[3])); w.z = cvt_pk_bf16(sigm(z1[0]), sigm(z1[1])); w.w = cvt_pk_bf16(sigm(z1[2]), sigm(z1[3]));
                    *(u32x4e*)(rp + bj * HALF) = w; } }
    }
};
struct EpiBr {
    static constexpr bool PERM = true, AFTER_DRAIN = false;
    const bf16_t* SG; bf16_t* Y;
    __device__ __forceinline__ void operator()(const f32x4 (&acc)[2][2][4][2], const Unit& u, int wr, int wc, int fr, int fq) const {
        const int br = u.pn >> 2;
        const int rowb = (u.pm & 127) * BM + wr * 64 + fr; const int cb = 256 * (u.pn & 3) + wc * 32 + 8 * fq;
#pragma unroll
        for (int ai = 0; ai < 2; ++ai) {
            u32x4e gq[4][2], oq[4][2];
#pragma unroll
            for (int m = 0; m < 4; ++m)
#pragma unroll
                for (int bj = 0; bj < 2; ++bj) { const size_t row = (size_t)(rowb + ai * HALF + m * 16); const int c = cb + bj * HALF;
                    gq[m][bj] = *(const u32x4e*)(SG + row * 3072 + br * 1024 + c); oq[m][bj] = br ? *(const u32x4e*)(Y + row * 1024 + c) : (u32x4e){0u, 0u, 0u, 0u}; }
#pragma unroll
            for (int m = 0; m < 4; ++m)
#pragma unroll
                for (int bj = 0; bj < 2; ++bj) { const size_t row = (size_t)(rowb + ai * HALF + m * 16); const int c = cb + bj * HALF; const f32x4 t0 = acc[ai][bj][m][0], t1 = acc[ai][bj][m][1];
                    const u32x4e g = gq[m][bj], o = oq[m][bj];
                    float y[8] = {bf_lo(g.x) * t0[0] + bf_lo(o.x), bf_hi(g.x) * t0[1] + bf_hi(o.x), bf_lo(g.y) * t0[2] + bf_lo(o.y), bf_hi(g.y) * t0[3] + bf_hi(o.y),
                                  bf_lo(g.z) * t1[0] + bf_lo(o.z), bf_hi(g.z) * t1[1] + bf_hi(o.z), bf_lo(g.w) * t1[2] + bf_lo(o.w), bf_hi(g.w) * t1[3] + bf_hi(o.w)};
                    *(u32x4e*)(Y + row * 1024 + c) = pack8v(y); }
            __builtin_amdgcn_sched_barrier(0);
        }
    }
};
struct BranchOrder {
    int G, c;
    __device__ bool next(int i, Unit& u) const {
        const int t = (i / 3) * G + c; if (t >= 512) return false; const int br = i % 3;
        const int wgid = (t % NXCD) * 64 + t / NXCD; const int pm = (wgid / 32) * 8 + (wgid % 32) % 8, pn = (wgid % 32) / 8;
        u.pm = br * 128 + pm; u.pn = br * 4 + pn; return true; }
    __device__ __forceinline__ void a_ready(const Unit&) const {}
    __device__ __forceinline__ void done(const Unit&) const {}
};
struct EpiOutLn {
    static constexpr bool PERM = true, AFTER_DRAIN = false;
    const float* res; float* out; bf16_t* xb; const float* g; const float* b; unsigned long long* xbuf; unsigned* cnt; float alpha; int write_xb;
    __device__ __forceinline__ void operator()(const f32x4 (&acc)[2][2][4][2], const Unit& u, int wr, int wc, int fr, int fq) const {
        typedef float f32x2v __attribute__((ext_vector_type(2)));
        const int tid = threadIdx.x, lane = tid & 63, wid = tid >> 6;
        PG8_LAS unsigned char* lt = (PG8_LAS unsigned char*)(uintptr_t)131072;
        PG8_LAS f32x2v* P = (PG8_LAS f32x2v*)lt; PG8_LAS f32x2v* S = (PG8_LAS f32x2v*)(lt + 8192); PG8_LAS unsigned* flag = (PG8_LAS unsigned*)(lt + 8192 + 2048);
        const int rowb = u.pm * BM + wr * 64 + fr; const int cb = 256 * u.pn + wc * 32 + 8 * fq;
#pragma unroll
        for (int ai = 0; ai < 2; ++ai) {
            f32x4 rq[4][2][2];
#pragma unroll
            for (int m = 0; m < 4; ++m)
#pragma unroll
                for (int bj = 0; bj < 2; ++bj)
#pragma unroll
                    for (int n = 0; n < 2; ++n) rq[m][bj][n] = *(const f32x4*)(res + (size_t)(rowb + ai * HALF + m * 16) * 1024 + cb + bj * HALF + 4 * n);
#pragma unroll
            for (int m = 0; m < 4; ++m) { const size_t off = (size_t)(rowb + ai * HALF + m * 16) * 1024 + cb;
                f32x4 v[2][2]; float sm = 0.f;
#pragma unroll
                for (int bj = 0; bj < 2; ++bj)
#pragma unroll
                    for (int n = 0; n < 2; ++n) { v[bj][n] = rq[m][bj][n] * alpha + acc[ai][bj][m][n]; sm += (v[bj][n][0] + v[bj][n][1]) + (v[bj][n][2] + v[bj][n][3]); }
#pragma unroll
                for (int bj = 0; bj < 2; ++bj)
#pragma unroll
                    for (int n = 0; n < 2; ++n) *(f32x4*)(out + off + bj * HALF + 4 * n) = v[bj][n];
                sm += __shfl_xor(sm, 16); sm += __shfl_xor(sm, 32);
                const float mw = sm * (1.0f / 64.0f); float q = 0.f;
#pragma unroll
                for (int bj = 0; bj < 2; ++bj)
#pragma unroll
                    for (int n = 0; n < 2; ++n) { const f32x4 d = v[bj][n] - mw; q += (d[0] * d[0] + d[1] * d[1]) + (d[2] * d[2] + d[3] * d[3]); }
                q += __shfl_xor(q, 16); q += __shfl_xor(q, 32);
                if (fq == 0) P[(ai * HALF + wr * 64 + m * 16 + fr) * 4 + wc] = (f32x2v){mw, q};
            }
            __builtin_amdgcn_sched_barrier(0);
        }
        asm volatile("s_waitcnt lgkmcnt(0)" ::: "memory"); __builtin_amdgcn_s_barrier(); asm volatile("" ::: "memory");
        const int row = wid * 32 + (lane & 31);
        if (lane < 32) {
            const f32x2v a = P[row * 4 + 0], b2 = P[row * 4 + 1], c = P[row * 4 + 2], d = P[row * 4 + 3];
            const float mt = (a.x + b2.x + c.x + d.x) * 0.25f;
            const float da = a.x - mt, db = b2.x - mt, dc = c.x - mt, dd = d.x - mt;
            const float m2 = (a.y + b2.y) + (c.y + d.y) + 64.0f * ((da * da + db * db) + (dc * dc + dd * dd));
            unsigned long long* slot = xbuf + ((size_t)(u.pm * BM + row) * 4 + u.pn);
            __hip_atomic_store(slot, ((unsigned long long)__float_as_uint(m2) << 32) | __float_as_uint(mt), __ATOMIC_RELAXED, __HIP_MEMORY_SCOPE_AGENT);
        }
        asm volatile("s_waitcnt vmcnt(0)" ::: "memory");
        if (lane == 0) __hip_atomic_fetch_add(cnt + 64 * u.pm, 1u, __ATOMIC_RELAXED, __HIP_MEMORY_SCOPE_AGENT);
        if (wid == 0) {
            unsigned spins = 0;
            while ((unsigned)__builtin_amdgcn_readfirstlane(__hip_atomic_load(cnt + 64 * u.pm, __ATOMIC_RELAXED, __HIP_MEMORY_SCOPE_AGENT)) < 32u && ++spins < (1u << 24)) __builtin_amdgcn_s_sleep(1);
            __builtin_amdgcn_fence(__ATOMIC_ACQUIRE, "agent");
            if (lane == 0) flag[0] = spins;
        }
        asm volatile("s_waitcnt vmcnt(0) lgkmcnt(0)" ::: "memory"); __builtin_amdgcn_s_barrier(); asm volatile("" ::: "memory");
        if (lane < 32) {
            const unsigned long long* slot = xbuf + (size_t)(u.pm * BM + row) * 4; float mt[4], m2[4]; float ms = 0.f;
#pragma unroll
            for (int t = 0; t < 4; ++t) { const unsigned long long w = __hip_atomic_load(slot + t, __ATOMIC_RELAXED, __HIP_MEMORY_SCOPE_AGENT); mt[t] = __uint_as_float((unsigned)w); m2[t] = __uint_as_float((unsigned)(w >> 32)); ms += mt[t]; }
            const float mean = ms * 0.25f; float q = 0.f;
#pragma unroll
            for (int t = 0; t < 4; ++t) { const float dm = mt[t] - mean; q += m2[t] + 256.0f * dm * dm; }
            S[row] = (f32x2v){mean, 1.0f / sqrtf(q * (1.0f / 1024.0f) + 1e-5f)};
        }
        asm volatile("s_waitcnt lgkmcnt(0)" ::: "memory"); __builtin_amdgcn_s_barrier(); asm volatile("" ::: "memory");
#pragma unroll
        for (int ai = 0; ai < 2; ++ai) {
            f32x4 vq[4][2][2];
#pragma unroll
            for (int m = 0; m < 4; ++m)
#pragma unroll
                for (int bj = 0; bj < 2; ++bj)
#pragma unroll
                    for (int n = 0; n < 2; ++n) vq[m][bj][n] = *(const f32x4*)(out + (size_t)(u.pm * BM + ai * HALF + wr * 64 + m * 16 + fr) * 1024 + cb + bj * HALF + 4 * n);
#pragma unroll
            for (int m = 0; m < 4; ++m) { const int r = ai * HALF + wr * 64 + m * 16 + fr; const f32x2v sr = S[r]; const size_t off = (size_t)(u.pm * BM + r) * 1024 + cb;
#pragma unroll
                for (int bj = 0; bj < 2; ++bj) { const f32x4 g0 = *(const f32x4*)(g + cb + bj * HALF), g1 = *(const f32x4*)(g + cb + bj * HALF + 4), b0 = *(const f32x4*)(b + cb + bj * HALF), b1 = *(const f32x4*)(b + cb + bj * HALF + 4);
                    const f32x4 y0 = (vq[m][bj][0] - sr.x) * sr.y * g0 + b0, y1 = (vq[m][bj][1] - sr.x) * sr.y * g1 + b1;
                    *(f32x4*)(out + off + bj * HALF) = y0; *(f32x4*)(out + off + bj * HALF + 4) = y1;
                    if (write_xb) { u32x4e w; w.x = cvt_pk_bf16(y0[0], y0[1]); w.y = cvt_pk_bf16(y0[2], y0[3]); w.z = cvt_pk_bf16(y1[0], y1[1]); w.w = cvt_pk_bf16(y1[2], y1[3]); *(u32x4e*)(xb + off + bj * HALF) = w; } } }
            __builtin_amdgcn_sched_barrier(0);
        }
    }
};
template <class Epi, class Sched, bool ALIGN_EPI = false, bool SP2 = false>
__device__ __forceinline__ void gemm_phase(PG8_LAS unsigned char* lds, const Gemm g, const Sched& S, const Epi& E) {
    int tid = threadIdx.x; asm volatile("" : "+v"(tid));
    const int wid = __builtin_amdgcn_readfirstlane(tid >> 6), lane = tid & 63, wr = wid >> 2, wc = wid & 3, fr = lane & 15, fq = lane >> 4;
    const int K = g.K, nt = K / BK;
    unsigned voffA[2], voffB[2];
#pragma unroll
    for (int i = 0; i < 2; ++i) { int R, C; stage_rc(tid * 16 + i * 8192, R, C); const int Rb = Epi::PERM ? ((R & ~31) + perm32(R & 31)) : R;
        voffA[i] = (unsigned)(R * K + C) * 2u; voffB[i] = (unsigned)(Rb * K + C) * 2u; }
    const size_t kstep = (size_t)(BK * 2);
    const size_t hstep = (size_t)HALF * K * 2;
    const size_t tstep = 2 * hstep;
    const unsigned ldsw = (unsigned)wid * 1024u;
    const int aoff = lds_byte(wr * 64 + fr, fq * 8), boff = lds_byte(wc * 32 + fr, fq * 8);
#define PG8_SA(b, h) (((b) * 2 + (h)) * HTB)
#define PG8_SB(b, h) ((4 + (b) * 2 + (h)) * HTB)
#define PG8_STAGE(bufoff, gbase, voff) do { _Pragma("unroll") for (int _i = 0; _i < 2; ++_i) \
        __builtin_amdgcn_global_load_lds((const unsigned*)((const char*)(gbase) + (voff)[_i]), (PG8_LAS unsigned*)(lds + (bufoff) + ldsw + _i * 8192), 16, 0, 0); } while (0)
#define PG8_LDA(dst, b, h) do { _Pragma("unroll") for (int m = 0; m < 4; ++m) _Pragma("unroll") for (int k = 0; k < 2; ++k) dst[m][k] = *(const PG8_LAS bf16x8*)(lds + PG8_SA(b, h) + aoff + m * 2048 + k * 1024); } while (0)
#define PG8_LDB(dst, b, h) do { _Pragma("unroll") for (int n = 0; n < 2; ++n) _Pragma("unroll") for (int k = 0; k < 2; ++k) dst[n][k] = *(const PG8_LAS bf16x8*)(lds + PG8_SB(b, h) + boff + n * 2048 + k * 1024); } while (0)
#define PG8_MMA(ai, bj, At, Bt) do { __builtin_amdgcn_s_setprio(1); _Pragma("unroll") for (int m = 0; m < 4; ++m) _Pragma("unroll") for (int n = 0; n < 2; ++n) _Pragma("unroll") for (int k = 0; k < 2; ++k) \
        acc[ai][bj][m][n] = __builtin_amdgcn_mfma_f32_16x16x32_bf16(Bt[n][k], At[m][k], acc[ai][bj][m][n], 0, 0, 0); __builtin_amdgcn_s_setprio(0); } while (0)
#define PG8_WAIT_V(n) asm volatile("s_waitcnt vmcnt(" #n ")" ::: "memory")
#define PG8_WAIT_L(n) asm volatile("s_waitcnt lgkmcnt(" #n ")" ::: "memory")
#define PG8_BAR __builtin_amdgcn_s_barrier()
#define PG8_SCHED __builtin_amdgcn_sched_barrier(0)
    Unit cur, nxt; int ui = 0;
    if (!S.next(0, cur)) return;
    f32x4 acc[2][2][4][2];
#pragma unroll
    for (int a = 0; a < 2; ++a)
#pragma unroll
        for (int b = 0; b < 2; ++b)
#pragma unroll
            for (int m = 0; m < 4; ++m)
#pragma unroll
                for (int n = 0; n < 2; ++n) acc[a][b][m][n] = (f32x4){0.f, 0.f, 0.f, 0.f};
    bf16x8 At[4][2], B0[2][2], B1[2][2];
    const char* cA = (const char*)g.A + (size_t)cur.pm * tstep; const char* cB = (const char*)g.Bt + (size_t)cur.pn * tstep;
    S.a_ready(cur);
    if constexpr (SP2) {
        PG8_STAGE(PG8_SB(0, 0), cB, voffB); PG8_STAGE(PG8_SB(0, 1), cB + hstep, voffB); PG8_STAGE(PG8_SA(0, 0), cA, voffA); PG8_STAGE(PG8_SA(0, 1), cA + hstep, voffA);
        if (wr == 1) PG8_BAR;
        PG8_WAIT_V(2); PG8_BAR;
        PG8_STAGE(PG8_SB(1, 0), cB + kstep, voffB); PG8_STAGE(PG8_SA(1, 0), cA + kstep, voffA); PG8_STAGE(PG8_SB(1, 1), cB + hstep + kstep, voffB);
        PG8_WAIT_V(6); PG8_BAR;
    } else {
        PG8_STAGE(PG8_SB(0, 0), cB, voffB); PG8_STAGE(PG8_SA(0, 0), cA, voffA); PG8_STAGE(PG8_SB(0, 1), cB + hstep, voffB); PG8_STAGE(PG8_SA(0, 1), cA + hstep, voffA);
        if (wr == 1) PG8_BAR;
        PG8_WAIT_V(4); PG8_BAR;
        PG8_STAGE(PG8_SB(1, 0), cB + kstep, voffB); PG8_STAGE(PG8_SA(1, 0), cA + kstep, voffA); PG8_STAGE(PG8_SB(1, 1), cB + hstep + kstep, voffB);
        PG8_WAIT_V(6); PG8_BAR;
    }
    for (;;) {
        const bool has_next = S.next(ui + 1, nxt);
        const char* nA = has_next ? (const char*)g.A + (size_t)nxt.pm * tstep : cA; const char* nB = has_next ? (const char*)g.Bt + (size_t)nxt.pn * tstep : cB;
        for (int t = 0; t < nt; t += 2) {
            const bool last = (t == nt - 2);
            const char* a1 = cA + (size_t)(t + 1) * kstep;
            const char* a2 = last ? nA : cA + (size_t)(t + 2) * kstep; const char* b2 = last ? nB : cB + (size_t)(t + 2) * kstep;
            const char* a3 = a2 + kstep; const char* b3 = b2 + kstep;
            if (last && has_next) S.a_ready(nxt);
            if constexpr (SP2) {
            PG8_LDB(B0, 0, 0); PG8_LDB(B1, 0, 1); PG8_SCHED; PG8_LDA(At, 0, 0); PG8_STAGE(PG8_SA(1, 1), a1 + hstep, voffA);
            PG8_WAIT_V(8); PG8_WAIT_L(0); PG8_BAR; PG8_MMA(0, 0, At, B0); PG8_MMA(0, 1, At, B1); PG8_BAR; PG8_SCHED;
            PG8_LDA(At, 0, 1); PG8_STAGE(PG8_SB(0, 0), b2, voffB); PG8_STAGE(PG8_SB(0, 1), b2 + hstep, voffB); PG8_STAGE(PG8_SA(0, 0), a2, voffA);
            PG8_WAIT_V(8); PG8_WAIT_L(0); PG8_BAR; PG8_MMA(1, 0, At, B0); PG8_MMA(1, 1, At, B1); PG8_BAR; PG8_SCHED;
            PG8_LDB(B0, 1, 0); PG8_LDB(B1, 1, 1); PG8_SCHED; PG8_LDA(At, 1, 0); PG8_STAGE(PG8_SA(0, 1), a2 + hstep, voffA);
            PG8_WAIT_V(8); PG8_WAIT_L(0); PG8_BAR; PG8_MMA(0, 0, At, B0); PG8_MMA(0, 1, At, B1); PG8_BAR; PG8_SCHED;
            PG8_LDA(At, 1, 1); PG8_STAGE(PG8_SB(1, 0), b3, voffB); PG8_STAGE(PG8_SB(1, 1), b3 + hstep, voffB); PG8_STAGE(PG8_SA(1, 0), a3, voffA);
            PG8_WAIT_V(8); PG8_WAIT_L(0); PG8_BAR; PG8_MMA(1, 0, At, B0); PG8_MMA(1, 1, At, B1); PG8_BAR; PG8_SCHED;
            } else {
            PG8_LDB(B0, 0, 0); PG8_SCHED; PG8_LDA(At, 0, 0); PG8_STAGE(PG8_SA(1, 1), a1 + hstep, voffA);
            PG8_WAIT_L(8); PG8_BAR; PG8_WAIT_L(0); PG8_MMA(0, 0, At, B0); PG8_BAR; PG8_SCHED;
            PG8_LDB(B1, 0, 1); PG8_STAGE(PG8_SB(0, 0), b2, voffB);
            PG8_BAR; PG8_WAIT_L(0); PG8_MMA(0, 1, At, B1); PG8_BAR;
            PG8_LDA(At, 0, 1); PG8_STAGE(PG8_SA(0, 0), a2, voffA);
            PG8_BAR; PG8_WAIT_L(0); PG8_MMA(1, 0, At, B0); PG8_BAR; PG8_SCHED;
            PG8_STAGE(PG8_SB(0, 1), b2 + hstep, voffB);
            PG8_WAIT_V(6); PG8_BAR; PG8_MMA(1, 1, At, B1); PG8_BAR;
            PG8_LDB(B0, 1, 0); PG8_SCHED; PG8_LDA(At, 1, 0); PG8_STAGE(PG8_SA(0, 1), a2 + hstep, voffA);
            PG8_WAIT_L(8); PG8_BAR; PG8_WAIT_L(0); PG8_MMA(0, 0, At, B0); PG8_BAR; PG8_SCHED;
            PG8_LDB(B1, 1, 1); PG8_STAGE(PG8_SB(1, 0), b3, voffB);
            PG8_BAR; PG8_WAIT_L(0); PG8_MMA(0, 1, At, B1); PG8_BAR;
            PG8_LDA(At, 1, 1); PG8_STAGE(PG8_SA(1, 0), a3, voffA);
            PG8_BAR; PG8_WAIT_L(0); PG8_MMA(1, 0, At, B0); PG8_BAR; PG8_SCHED;
            PG8_STAGE(PG8_SB(1, 1), b3 + hstep, voffB);
            PG8_WAIT_V(6); PG8_BAR; PG8_MMA(1, 1, At, B1); PG8_BAR;
            }
        }
        if constexpr (ALIGN_EPI) { if (wr == 0) PG8_BAR; }
        if constexpr (!Epi::AFTER_DRAIN) { E(acc, cur, wr, wc, fr, fq); S.done(cur); }
        if (!has_next) break;
#pragma unroll
        for (int a = 0; a < 2; ++a)
#pragma unroll
            for (int b = 0; b < 2; ++b)
#pragma unroll
                for (int m = 0; m < 4; ++m)
#pragma unroll
                    for (int n = 0; n < 2; ++n) acc[a][b][m][n] = (f32x4){0.f, 0.f, 0.f, 0.f};
        cur = nxt; cA = nA; cB = nB; ++ui;
        if constexpr (ALIGN_EPI) { if (wr == 1) PG8_BAR; }
    }
    PG8_WAIT_V(0);
    if constexpr (!ALIGN_EPI) { if (wr == 0) PG8_BAR; }
    PG8_BAR;
    if constexpr (Epi::AFTER_DRAIN) { E.fused(acc, cur, wr, wc, fr, fq, lds, wid, lane); S.done(cur); }
#undef PG8_SA
#undef PG8_SB
#undef PG8_STAGE
#undef PG8_LDA
#undef PG8_LDB
#undef PG8_MMA
#undef PG8_WAIT_V
#undef PG8_WAIT_L
#undef PG8_BAR
#undef PG8_SCHED
}
}
#include <hip/hip_bf16.h>
#include <cmath>
namespace attn_body {
using bf16=__hip_bfloat16;
using bf16x8=__attribute__((ext_vector_type(8)))short;
using s16x4=__attribute__((ext_vector_type(4)))short;
using f32x16=__attribute__((ext_vector_type(16)))float;
using u32x4=__attribute__((ext_vector_type(4)))unsigned;
constexpr int BATCH=2,NHEAD=8,SEQ=16384,D=64,QP=512,KP=128,GQ=4;
constexpr int NW=8,QBLK=32,QB=QBLK*NW,KVBLK=64,NQB=SEQ/QB;
constexpr int ATTN_UNIT_ROWS=QB;
__device__ __forceinline__ int crow(int r,int hi){return (r&3)+8*(r>>2)+4*hi;}
#define SBAR() __builtin_amdgcn_sched_barrier(0)
constexpr int NSLOT=3, SLOTB=8192;
constexpr int LDS_K=0, LDS_V=NSLOT*SLOTB, LDS_WS=2*NSLOT*SLOTB, LDS_OST=LDS_WS+NW*64*4, LDS_BYTES=LDS_OST+NW*4096;
constexpr float C2=0.125f*1.4426950408889634f;
__device__ __forceinline__ void glds16(const void*gsrc,unsigned lds_dst){unsigned keep;
  asm volatile("s_mov_b32 %0, m0\n\ts_mov_b32 m0, %2\n\ts_nop 0\n\tglobal_load_lds_dwordx4 %1, off\n\ts_mov_b32 m0, %0":"=&s"(keep):"v"(gsrc),"s"(lds_dst):"memory");}
__device__ __forceinline__ float fadd_s(float a,float b){float r;asm("v_add_f32_e32 %0, %1, %2":"=v"(r):"v"(a),"v"(b));return r;}
__device__ __forceinline__ float fsub_s(float a,float b){float r;asm("v_sub_f32_e32 %0, %1, %2":"=v"(r):"v"(a),"v"(b));return r;}
typedef float f32x2_t __attribute__((ext_vector_type(2))); typedef __bf16 bf16x2_t __attribute__((ext_vector_type(2)));
__device__ __forceinline__ unsigned cvtpk_s(float lo,float hi){f32x2_t v={lo,hi};bf16x2_t b=__builtin_convertvector(v,bf16x2_t);return __builtin_bit_cast(unsigned,b);}
#define WAIT_BAR(N) asm volatile("s_waitcnt vmcnt(" #N ") lgkmcnt(0)\n\ts_barrier":::"memory")

__device__ __forceinline__ void qkt(f32x16&p0,f32x16&p1,const char*Kslot,const bf16x8*qr,const f32x16&negm,int r32,int hi){
  const char*kb=Kslot+hi*1024+r32*16;
  #pragma unroll
  for(int d0=0;d0<4;++d0){
    const bf16x8 b0=*reinterpret_cast<const bf16x8*>(kb+d0*2048);
    const bf16x8 b1=*reinterpret_cast<const bf16x8*>(kb+d0*2048+512);
    if(d0==0){p0=__builtin_amdgcn_mfma_f32_32x32x16_bf16(b0,qr[0],negm,0,0,0);p1=__builtin_amdgcn_mfma_f32_32x32x16_bf16(b1,qr[0],negm,0,0,0);}
    else{p0=__builtin_amdgcn_mfma_f32_32x32x16_bf16(b0,qr[d0],p0,0,0,0);p1=__builtin_amdgcn_mfma_f32_32x32x16_bf16(b1,qr[d0],p1,0,0,0);}}
}
typedef __attribute__((address_space(3))) const char* lds_cptr;
typedef short v4i16_t __attribute__((ext_vector_type(4)));
__device__ __forceinline__ void kload8(bf16x8*kf,lds_cptr kp){
  kf[0]=*(const __attribute__((address_space(3))) bf16x8*)(kp);      kf[1]=*(const __attribute__((address_space(3))) bf16x8*)(kp+512);
  kf[2]=*(const __attribute__((address_space(3))) bf16x8*)(kp+2048); kf[3]=*(const __attribute__((address_space(3))) bf16x8*)(kp+2560);
  kf[4]=*(const __attribute__((address_space(3))) bf16x8*)(kp+4096); kf[5]=*(const __attribute__((address_space(3))) bf16x8*)(kp+4608);
  kf[6]=*(const __attribute__((address_space(3))) bf16x8*)(kp+6144); kf[7]=*(const __attribute__((address_space(3))) bf16x8*)(kp+6656);
}
__device__ __forceinline__ void kload2(bf16x8*kf,lds_cptr kp,int j){ kf[2*j]=*(const __attribute__((address_space(3))) bf16x8*)(kp+j*2048); kf[2*j+1]=*(const __attribute__((address_space(3))) bf16x8*)(kp+j*2048+512); }
__device__ __forceinline__ s16x4 vtr(lds_cptr p){ return __builtin_bit_cast(s16x4,__builtin_amdgcn_ds_read_tr16_b64_v4i16((__attribute__((address_space(3))) v4i16_t*)p)); }
__device__ __forceinline__ void pv(f32x16*o,int vb,bf16x8 pa0,bf16x8 pa1,bf16x8 pa2,bf16x8 pa3){
  #pragma unroll
  for(int d0=0;d0<2;++d0){s16x4 lo[4],hi[4];
    #pragma unroll
    for(int ks=0;ks<4;++ks){
      asm volatile("ds_read_b64_tr_b16 %0,%1 offset:%c2":"=&v"(lo[ks]):"v"(vb),"i"(d0*4096+ks*1024):"memory");
      asm volatile("ds_read_b64_tr_b16 %0,%1 offset:%c2":"=&v"(hi[ks]):"v"(vb),"i"(d0*4096+ks*1024+512):"memory");}
    asm volatile("s_waitcnt lgkmcnt(0)":::"memory");SBAR();
    #define PK(k) (bf16x8){lo[k][0],lo[k][1],lo[k][2],lo[k][3],hi[k][0],hi[k][1],hi[k][2],hi[k][3]}
    o[d0]=__builtin_amdgcn_mfma_f32_32x32x16_bf16(pa0,PK(0),o[d0],0,0,0);
    o[d0]=__builtin_amdgcn_mfma_f32_32x32x16_bf16(pa1,PK(1),o[d0],0,0,0);
    o[d0]=__builtin_amdgcn_mfma_f32_32x32x16_bf16(pa2,PK(2),o[d0],0,0,0);
    o[d0]=__builtin_amdgcn_mfma_f32_32x32x16_bf16(pa3,PK(3),o[d0],0,0,0);
    #undef PK
  }
}

#ifndef ATTN_STORE16
#define ATTN_STORE16(p,v) (*(u32x4*)(p)=(v))
#endif
template<int THRL> __device__ __forceinline__ void attn_unit(int b,int h,int qb,const bf16*Q,const bf16*__restrict__ K,const bf16*__restrict__ V,bf16*O,char*shm,const float Mref){
  int tid=threadIdx.x; asm volatile("":"+v"(tid)); const int lane=tid&63,r32=lane&31,hi=lane>>5; const int wid=__builtin_amdgcn_readfirstlane(tid>>6);
  const long rowbase=(long)b*SEQ; const int q0=qb*QB;
  const bf16*Qw=Q+(rowbase+q0+wid*QBLK)*QP+h*D;
  const bf16*Kh=K+rowbase*KP+(h/GQ)*D,*Vh=V+rowbase*KP+(h/GQ)*D;
  const unsigned lds0=(unsigned)(uintptr_t)shm;
  float*wsf=(float*)(shm+LDS_WS)+wid*64;
  const bf16*ksrc=Kh+(long)lane*KP+wid*8;
  const bf16*vsrc=Vh+(long)(16*(wid&3)+(lane>>2))*KP+(wid>>2)*32+(lane&3)*8;
  const unsigned kdst=lds0+LDS_K+wid*1024, vdst=lds0+LDS_V+wid*1024;
  #define DMA_K(t,slot) glds16(ksrc+(long)(t)*KVBLK*KP,(unsigned)__builtin_amdgcn_readfirstlane(kdst+(slot)))
  #define DMA_V(t,slot) glds16(vsrc+(long)(t)*KVBLK*KP,(unsigned)__builtin_amdgcn_readfirstlane(vdst+(slot)))
  const int vb0=(int)(lds0+LDS_V)+((lane>>4)&1)*32+(lane&3)*8+(4*hi+((lane&15)>>2))*64;
  const char*Kbase=shm+LDS_K; bf16x8 kf[8];
  const lds_cptr shm3=(lds_cptr)shm; const lds_cptr kp0=shm3+LDS_K+hi*1024+r32*16; const lds_cptr vp0=shm3+LDS_V+((lane>>4)&1)*32+(lane&3)*8+(4*hi+((lane&15)>>2))*64;
  const int NT=SEQ/KVBLK;
  DMA_K(0,0);DMA_V(0,0);DMA_K(1,SLOTB);
  bf16x8 qr[4];
  #pragma unroll
  for(int d0=0;d0<4;++d0)qr[d0]=*reinterpret_cast<const bf16x8*>(&Qw[(long)r32*QP+d0*16+hi*8]);
  float mhat=0.f,l_reg=0.f;f32x16 o[2];o[0]=f32x16{};o[1]=f32x16{};f32x16 negm=f32x16{};asm volatile("":"+v"(negm));
  #define CMASK(P0,P1,t) do{}while(0)
  bool resc=false;
  #define START(P0,P1) do{ const float rm=Mref; resc=false; \
    { const float dl=rm; mhat=fadd_s(mhat,dl); \
      _Pragma("unroll") for(int r=0;r<16;++r){P0[r]=fsub_s(P0[r],dl);P1[r]=fsub_s(P1[r],dl);} \
      _Pragma("unroll") for(int r=0;r<16;++r)negm[r]=-mhat; asm volatile("":"+v"(negm)); } \
    _Pragma("unroll") for(int r=0;r<16;++r)P0[r]=__builtin_amdgcn_exp2f(P0[r]); }while(0)
  #define RESC() do{}while(0)
  f32x16 pA0,pA1,pB0,pB1;
  int sl_prev=0,sl_cur=0,sl_next=SLOTB;
  #define ROT() do{sl_prev=sl_cur;sl_cur=sl_next;sl_next=(sl_next==(NSLOT-1)*SLOTB)?0:sl_next+SLOTB;}while(0)
  DMA_K(2,2*SLOTB);
  WAIT_BAR(3);
  qkt(pA0,pA1,Kbase,qr,negm,r32,hi);asm volatile("s_nop 15\n\ts_nop 7":"+v"(pA0),"+v"(pA1));CMASK(pA0,pA1,0);
  START(pA0,pA1);
  _Pragma("unroll") for(int r=0;r<16;++r)pA1[r]=__builtin_amdgcn_exp2f(pA1[r]);
  WAIT_BAR(0);
  DMA_K(3,0);DMA_V(1,SLOTB);
  ROT();
  kload8(kf,kp0+sl_cur);
  WAIT_BAR(2);
  s16x4 vlo[8],vhi[8]; u32x4 pw0,pw1,pw2,pw3;
  #define PKW(P,B) cvtpk_s(P[B],P[B+1])
  #define PAF(k) __builtin_bit_cast(bf16x8,pw##k)
  #define VFR(i) (bf16x8){vlo[i][0],vlo[i][1],vlo[i][2],vlo[i][3],vhi[i][0],vhi[i][1],vhi[i][2],vhi[i][3]}
  #define PIN(x) asm volatile("":"+v"(x))
  #define GAPA(MF,A0,A1,A2,A3,W0,W1,PW) do{ MF; sacc+=A0; sacc+=A1; sacc+=A2; sacc+=A3; PIN(sacc); W0; W1; PIN(PW); SBAR(); }while(0)
  #define EX(v) __builtin_amdgcn_exp2f(v)
  #define GAPB(MF,X,B) do{ MF; X[B]=EX(X[B]); X[B+1]=EX(X[B+1]); X[B+2]=EX(X[B+2]); X[B+3]=EX(X[B+3]); PIN(X); SBAR(); }while(0)
  #define VRD(i) do{ vlo[i]=vtr(vp_+(((i)>>2)*4096+((i)&3)*1024)); vhi[i]=vtr(vp_+(((i)>>2)*4096+((i)&3)*1024+512)); }while(0)
  #define KRD(G,j) do{ if(G){ kload2(kf,kp0+sl_next,j); SBAR(); } }while(0)
  #define STEP(C0,C1,P0,P1,t,GK,GV,GL) do{ SBAR(); \
    const lds_cptr vp_=vp0+sl_prev; \
    VRD(0); SBAR(); float sacc=(P0[0]+P0[1]); \
    GAPA(C0=__builtin_amdgcn_mfma_f32_32x32x16_bf16(kf[0],qr[0],negm,0,0,0), P0[2],P0[3],P0[4],P0[5],     pw0[0]=PKW(P0,0), pw0[1]=PKW(P0,2), pw0); \
    VRD(4); SBAR(); GAPA(C1=__builtin_amdgcn_mfma_f32_32x32x16_bf16(kf[1],qr[0],negm,0,0,0), P0[6],P0[7],P0[8],P0[9],     pw0[2]=PKW(P0,4), pw0[3]=PKW(P0,6), pw0); \
    VRD(1); SBAR(); GAPA(C0=__builtin_amdgcn_mfma_f32_32x32x16_bf16(kf[2],qr[1],C0,0,0,0),   P0[10],P0[11],P0[12],P0[13], pw1[0]=PKW(P0,8), pw1[1]=PKW(P0,10), pw1); \
    VRD(5); SBAR(); GAPA(C1=__builtin_amdgcn_mfma_f32_32x32x16_bf16(kf[3],qr[1],C1,0,0,0),   P0[14],P0[15],P1[0],P1[1],   pw1[2]=PKW(P0,12),pw1[3]=PKW(P0,14), pw1); \
    VRD(2); SBAR(); GAPA(C0=__builtin_amdgcn_mfma_f32_32x32x16_bf16(kf[4],qr[2],C0,0,0,0),   P1[2],P1[3],P1[4],P1[5],     pw2[0]=PKW(P1,0), pw2[1]=PKW(P1,2), pw2); \
    VRD(6); SBAR(); GAPA(C1=__builtin_amdgcn_mfma_f32_32x32x16_bf16(kf[5],qr[2],C1,0,0,0),   P1[6],P1[7],P1[8],P1[9],     pw2[2]=PKW(P1,4), pw2[3]=PKW(P1,6), pw2); \
    VRD(3); SBAR(); GAPA(C0=__builtin_amdgcn_mfma_f32_32x32x16_bf16(kf[6],qr[3],C0,0,0,0),   P1[10],P1[11],P1[12],P1[13], pw3[0]=PKW(P1,8), pw3[1]=PKW(P1,10), pw3); \
    VRD(7); SBAR(); GAPA(C1=__builtin_amdgcn_mfma_f32_32x32x16_bf16(kf[7],qr[3],C1,0,0,0),   P1[14],P1[15],0.f,0.f,       pw3[2]=PKW(P1,12),pw3[3]=PKW(P1,14), pw3); \
    l_reg+=sacc; \
    if(GK){DMA_K((t)+3,sl_cur);} if(GV){DMA_V((t)+1,sl_next);} \
    CMASK(C0,C1,t); \
    SBAR(); \
    GAPB(o[0]=__builtin_amdgcn_mfma_f32_32x32x16_bf16(PAF(0),VFR(0),o[0],0,0,0), C0,0); \
    GAPB(o[1]=__builtin_amdgcn_mfma_f32_32x32x16_bf16(PAF(0),VFR(4),o[1],0,0,0), C0,4); \
    KRD(GL,0); GAPB(o[0]=__builtin_amdgcn_mfma_f32_32x32x16_bf16(PAF(1),VFR(1),o[0],0,0,0), C0,8); \
    KRD(GL,1); GAPB(o[1]=__builtin_amdgcn_mfma_f32_32x32x16_bf16(PAF(1),VFR(5),o[1],0,0,0), C0,12); \
    KRD(GL,2); GAPB(o[0]=__builtin_amdgcn_mfma_f32_32x32x16_bf16(PAF(2),VFR(2),o[0],0,0,0), C1,0); \
    KRD(GL,3); GAPB(o[1]=__builtin_amdgcn_mfma_f32_32x32x16_bf16(PAF(2),VFR(6),o[1],0,0,0), C1,4); \
    GAPB(o[0]=__builtin_amdgcn_mfma_f32_32x32x16_bf16(PAF(3),VFR(3),o[0],0,0,0), C1,8); \
    GAPB(o[1]=__builtin_amdgcn_mfma_f32_32x32x16_bf16(PAF(3),VFR(7),o[1],0,0,0), C1,12); \
    }while(0)
  int t=1;
  #undef CMASK
  #define CMASK(P0,P1,t) do{}while(0)
  for(;t+5<NT;t+=2){
    STEP(pB0,pB1,pA0,pA1,t,true,true,true);     WAIT_BAR(2); RESC(); ROT();
    STEP(pA0,pA1,pB0,pB1,t+1,true,true,true);   WAIT_BAR(2); RESC(); ROT();
  }
  #undef CMASK
  #define CMASK(P0,P1,t) do{}while(0)
  #define ENDW(tt) do{ if((tt)+3<NT){WAIT_BAR(2);} else if((tt)+2<NT){WAIT_BAR(1);} else {WAIT_BAR(0);} }while(0)
  for(;t+1<NT;t+=2){
    STEP(pB0,pB1,pA0,pA1,t,(t+3<NT),(t+1<NT),(t+1<NT));       ENDW(t);   RESC(); ROT();
    STEP(pA0,pA1,pB0,pB1,t+1,(t+4<NT),(t+2<NT),(t+2<NT));     ENDW(t+1); RESC(); ROT();
  }
  STEP(pB0,pB1,pA0,pA1,NT-1,false,false,false); RESC();
  { float sacc=pB0[0]+pB0[1]; _Pragma("unroll") for(int r=2;r<16;++r)sacc+=pB0[r]; _Pragma("unroll") for(int r=0;r<16;++r)sacc+=pB1[r]; l_reg+=sacc;
    pw0=(u32x4){PKW(pB0,0),PKW(pB0,2),PKW(pB0,4),PKW(pB0,6)};pw1=(u32x4){PKW(pB0,8),PKW(pB0,10),PKW(pB0,12),PKW(pB0,14)};pw2=(u32x4){PKW(pB1,0),PKW(pB1,2),PKW(pB1,4),PKW(pB1,6)};pw3=(u32x4){PKW(pB1,8),PKW(pB1,10),PKW(pB1,12),PKW(pB1,14)};
    SBAR(); pv(o,vb0+sl_cur,PAF(0),PAF(1),PAF(2),PAF(3)); }
  #undef PKW
  #undef PAF
  #undef VFR
  #undef PIN
  #undef GAPA
  #undef GAPB
  #undef EX
  #undef VRD
  #undef KRD
  #undef STEP
  #undef ENDW
  {auto rr=__builtin_amdgcn_permlane32_swap(__float_as_uint(l_reg),__float_as_uint(l_reg),false,false);l_reg=__uint_as_float(rr[0])+__uint_as_float(rr[1]);}
  if(hi==0)wsf[32+r32]=l_reg;asm volatile("s_waitcnt lgkmcnt(0)":::"memory");
  float rli[16];
  #pragma unroll
  for(int r=0;r<16;++r)rli[r]=__builtin_amdgcn_rcpf(wsf[32+crow(r,hi)]);
  bf16*Ow=O+(rowbase+q0+wid*QBLK)*QP+h*D;
  { bf16*stg=(bf16*)(shm+LDS_OST)+wid*2048;
    #pragma unroll
    for(int r=0;r<16;++r){const int orow=crow(r,hi);
      #pragma unroll
      for(int d0=0;d0<2;++d0)stg[orow*64+d0*32+r32]=__float2bfloat16(o[d0][r]*rli[r]);}
    asm volatile("s_waitcnt lgkmcnt(0)":::"memory");
    #pragma unroll
    for(int i=0;i<4;++i){const int row=i*8+(lane>>3),ch=lane&7; const u32x4 v=*(const u32x4*)(stg+row*64+ch*8); ATTN_STORE16(Ow+(long)row*QP+ch*8,v);} }
  asm volatile("s_waitcnt lgkmcnt(0)\n\ts_barrier":::"memory");
  #undef DMA_K
  #undef DMA_V
  #undef CMASK
  #undef START
  #undef RESC
  #undef ROT
}
constexpr int ATTN_LDS_BYTES=LDS_BYTES;
struct AttnTensors { const bf16* Q; const bf16* K; const bf16* V; bf16* O; };
template<int THRL=8> __device__ __forceinline__ void attn_phase(char*lds,const AttnTensors&T,int vcu,int G,const float Mref){
  constexpr int NU=BATCH*NHEAD*NQB; const bool packed=(G*4==NU);
  for(int i=0;;++i){ const int u=packed?((i<4)?vcu*4+i:NU):(vcu+i*G); if(u>=NU)break; const int bh=u/NQB, qb=u%NQB; attn_unit<THRL>(bh/NHEAD,bh%NHEAD,qb,T.Q,T.K,T.V,T.O,lds,Mref); }
}
#undef SBAR
#undef WAIT_BAR
}
namespace mix {
typedef unsigned short bf16_t;
typedef short bf16x8 __attribute__((ext_vector_type(8)));
typedef float f32x4 __attribute__((ext_vector_type(4)));
typedef unsigned u32x4 __attribute__((ext_vector_type(4)));
constexpr int L = 16384;
#define RLAS __attribute__((address_space(3)))
#define MFMA16(a, b, c) __builtin_amdgcn_mfma_f32_16x16x32_bf16(a, b, c, 0, 0, 0)
__device__ __forceinline__ unsigned pk(float lo, float hi) { return pg8::cvt_pk_bf16(lo, hi); }
__device__ __forceinline__ bf16x8 ld8(const bf16_t* p) { return *(const bf16x8*)p; }
__device__ __forceinline__ bf16x8 pack8(float a0, float a1, float a2, float a3, float a4, float a5, float a6, float a7) {
    u32x4 w; w.x = pk(a0, a1); w.y = pk(a2, a3); w.z = pk(a4, a5); w.w = pk(a6, a7); return __builtin_bit_cast(bf16x8, w); }
__device__ __forceinline__ bf16_t bf1(float f) { return (bf16_t)(pk(f, 0.f) & 0xffffu); }
__device__ __forceinline__ float log2_sigmoid(float th) { return -log1pf(expf(-th)) * 1.4426950408889634f; }

__device__ __forceinline__ void ret_kv_block(int cu, int tid, RLAS unsigned char* lds, const bf16_t* RKT, const bf16_t* RVT, bf16_t* ST, const float* thf, const float* thb) {
    const int b = cu >> 9, h = (cu >> 7) & 3, n = cu & 127; const int lane = tid & 63, w = tid >> 6, g = lane >> 4, c16 = lane & 15, eb = w & 3, dh = w >> 2;
    const float l2f = log2_sigmoid(thf[h]), l2b = log2_sigmoid(thb[h]);
    {
        bf16x8 kq[4], vq[4];
#pragma unroll
        for (int i = 0; i < 4; ++i) { const int p = tid + 512 * i, row = p >> 4, cc = p & 15; const size_t src = ((size_t)((b * 4 + h) * 128 + row)) * L + n * 128 + cc * 8;
            kq[i] = ld8(RKT + src); vq[i] = ld8(RVT + src); }
#pragma unroll
        for (int i = 0; i < 4; ++i) { const int p = tid + 512 * i, row = p >> 4, cc = p & 15;
            *(RLAS bf16x8*)(lds + row * 256 + ((cc ^ (row & 15)) << 4)) = kq[i];
            *(RLAS bf16x8*)(lds + 32768 + row * 256 + ((cc ^ (row & 15)) << 4)) = vq[i]; }
    }
    __syncthreads();
    f32x4 aF[2][4], aB[2][4];
#pragma unroll
    for (int et = 0; et < 2; ++et)
#pragma unroll
        for (int dt = 0; dt < 4; ++dt) { aF[et][dt] = (f32x4){0.f, 0.f, 0.f, 0.f}; aB[et][dt] = (f32x4){0.f, 0.f, 0.f, 0.f}; }
#pragma unroll
    for (int ks = 0; ks < 4; ++ks) {
        float wf[8], wb[8];
#pragma unroll
        for (int jj = 0; jj < 8; ++jj) { const int j = ks * 32 + 8 * g + jj; wf[jj] = __builtin_amdgcn_exp2f((float)(127 - j) * l2f); wb[jj] = __builtin_amdgcn_exp2f((float)j * l2b); }
        bf16x8 Af[2], Ab[2];
#pragma unroll
        for (int et = 0; et < 2; ++et) { const int row = eb * 32 + et * 16 + c16;
            const u32x4 v = __builtin_bit_cast(u32x4, *(const RLAS bf16x8*)(lds + 32768 + row * 256 + (((ks * 4 + g) ^ (row & 15)) << 4)));
            float x[8] = {pg8::bf_lo(v.x), pg8::bf_hi(v.x), pg8::bf_lo(v.y), pg8::bf_hi(v.y), pg8::bf_lo(v.z), pg8::bf_hi(v.z), pg8::bf_lo(v.w), pg8::bf_hi(v.w)};
            Af[et] = pack8(x[0] * wf[0], x[1] * wf[1], x[2] * wf[2], x[3] * wf[3], x[4] * wf[4], x[5] * wf[5], x[6] * wf[6], x[7] * wf[7]);
            Ab[et] = pack8(x[0] * wb[0], x[1] * wb[1], x[2] * wb[2], x[3] * wb[3], x[4] * wb[4], x[5] * wb[5], x[6] * wb[6], x[7] * wb[7]); }
#pragma unroll
        for (int dt = 0; dt < 4; ++dt) { const int row = dh * 64 + dt * 16 + c16; const bf16x8 bk = *(const RLAS bf16x8*)(lds + row * 256 + (((ks * 4 + g) ^ (row & 15)) << 4));
#pragma unroll
            for (int et = 0; et < 2; ++et) { aF[et][dt] = MFMA16(bk, Af[et], aF[et][dt]); aB[et][dt] = MFMA16(bk, Ab[et], aB[et][dt]); } }
    }
    bf16_t* SF = ST + ((size_t)(((0 * 2 + b) * 4 + h) * 128 + n)) * 16384; bf16_t* SB = ST + ((size_t)(((1 * 2 + b) * 4 + h) * 128 + n)) * 16384;
    typedef unsigned u32x2m __attribute__((ext_vector_type(2)));
#pragma unroll
    for (int et = 0; et < 2; ++et)
#pragma unroll
        for (int dt = 0; dt < 4; ++dt)
            { const int e = eb * 32 + et * 16 + c16, d0 = dh * 64 + dt * 16 + 4 * g; u32x2m wf_, wb_; wf_.x = pk(aF[et][dt][0], aF[et][dt][1]); wf_.y = pk(aF[et][dt][2], aF[et][dt][3]); wb_.x = pk(aB[et][dt][0], aB[et][dt][1]); wb_.y = pk(aB[et][dt][2], aB[et][dt][3]);
              *(u32x2m*)(SF + e * 128 + d0) = wf_; *(u32x2m*)(SB + e * 128 + d0) = wb_; }
    __syncthreads();
}
__device__ __forceinline__ int ret_keyk(int row) { return (((row >> 3) & 3) << 2) | (row & 3); }
__device__ __forceinline__ void ret_out_block(int cu, int tid, RLAS unsigned char* lds, bf16_t* OA, const bf16_t* RK, const bf16_t* RVT, const bf16_t* ST, const float* thf, const float* thb, const float* gain) {
    const int b = cu >> 9, h = (cu >> 7) & 3, n = cu & 127; const int lane = tid & 63, ib = tid >> 6, g = lane >> 4, c16 = lane & 15;
    const float l2f = log2_sigmoid(thf[h]), l2b = log2_sigmoid(thb[h]);
    const size_t tok0 = (size_t)b * L + n * 128;
    {
        const bf16_t* SFg = ST + ((size_t)(((0 * 2 + b) * 4 + h) * 128 + n)) * 16384; const bf16_t* SBg = ST + ((size_t)(((1 * 2 + b) * 4 + h) * 128 + n)) * 16384;
#pragma unroll 1
        for (int hf = 0; hf < 2; ++hf) {
            bf16x8 kq[2], vq[2], fq_[2], bq_[2];
#pragma unroll
            for (int i = 0; i < 2; ++i) { const int p = tid + 512 * (2 * hf + i), row = p >> 4, cc = p & 15;
                kq[i] = ld8(RK + (tok0 + row) * 512 + h * 128 + cc * 8);
                vq[i] = ld8(RVT + ((size_t)((b * 4 + h) * 128 + row)) * L + n * 128 + cc * 8);
                fq_[i] = ld8(SFg + row * 128 + cc * 8); bq_[i] = ld8(SBg + row * 128 + cc * 8); }
#pragma unroll
            for (int i = 0; i < 2; ++i) { const int p = tid + 512 * (2 * hf + i), row = p >> 4, cc = p & 15;
                *(RLAS bf16x8*)(lds + row * 256 + ((cc ^ ret_keyk(row)) << 4)) = kq[i];
                *(RLAS bf16x8*)(lds + 32768 + row * 256 + ((cc ^ (row & 15)) << 4)) = vq[i];
                *(RLAS bf16x8*)(lds + 65536 + row * 256 + ((cc ^ (row & 15)) << 4)) = fq_[i];
                *(RLAS bf16x8*)(lds + 98304 + row * 256 + ((cc ^ (row & 15)) << 4)) = bq_[i]; }
        }
    }
    const bf16_t* Qp = OA + (tok0 + ib * 16 + c16) * 512 + h * 128 + 8 * g;
    bf16x8 qf[4];
#pragma unroll
    for (int ks = 0; ks < 4; ++ks) qf[ks] = ld8(Qp + ks * 32);
    __syncthreads();
    f32x4 aI[8], aF[8], aB[8];
#pragma unroll
    for (int et = 0; et < 8; ++et) { aI[et] = (f32x4){0.f, 0.f, 0.f, 0.f}; aF[et] = aI[et]; aB[et] = aI[et]; }
    const int iq = ib * 16 + c16;
    const int slot0 = 8 * (c16 >> 2) + (c16 & 3);
#pragma unroll
    for (int kg = 0; kg < 4; ++kg) {
        f32x4 s0 = (f32x4){0.f, 0.f, 0.f, 0.f}, s1 = s0;
        const int r0 = kg * 32 + slot0, r1 = r0 + 4;
#pragma unroll
        for (int ks = 0; ks < 4; ++ks) {
            s0 = MFMA16(*(const RLAS bf16x8*)(lds + r0 * 256 + (((ks * 4 + g) ^ ret_keyk(r0)) << 4)), qf[ks], s0);
            s1 = MFMA16(*(const RLAS bf16x8*)(lds + r1 * 256 + (((ks * 4 + g) ^ ret_keyk(r1)) << 4)), qf[ks], s1); }
        float p[8];
#pragma unroll
        for (int i = 0; i < 4; ++i) {
            const int j0 = kg * 32 + 8 * g + i, j1 = j0 + 4; const int d0 = iq - j0, d1 = iq - j1;
            const float e0 = d0 >= 0 ? (float)d0 * l2f : (float)(-d0) * l2b, e1 = d1 >= 0 ? (float)d1 * l2f : (float)(-d1) * l2b;
            p[i] = s0[i] * __builtin_amdgcn_exp2f(e0); p[4 + i] = s1[i] * __builtin_amdgcn_exp2f(e1); }
        const bf16x8 pf = pack8(p[0], p[1], p[2], p[3], p[4], p[5], p[6], p[7]);
#pragma unroll
        for (int et = 0; et < 8; ++et) { const int row = et * 16 + c16; aI[et] = MFMA16(pf, *(const RLAS bf16x8*)(lds + 32768 + row * 256 + (((kg * 4 + g) ^ (row & 15)) << 4)), aI[et]); }
    }
#pragma unroll
    for (int ks = 0; ks < 4; ++ks)
#pragma unroll
        for (int et = 0; et < 8; ++et) { const int row = et * 16 + c16; const int off = row * 256 + (((ks * 4 + g) ^ (row & 15)) << 4);
            aF[et] = MFMA16(qf[ks], *(const RLAS bf16x8*)(lds + 65536 + off), aF[et]);
            aB[et] = MFMA16(qf[ks], *(const RLAS bf16x8*)(lds + 98304 + off), aB[et]); }
    float gn[8];
#pragma unroll
    for (int et = 0; et < 8; ++et) gn[et] = gain[h * 128 + et * 16 + c16];
#pragma unroll
    for (int i = 0; i < 4; ++i) {
        const int iq2 = ib * 16 + 4 * g + i; const float wq_f = __builtin_amdgcn_exp2f((float)(iq2 + 1) * l2f), wq_b = __builtin_amdgcn_exp2f((float)(128 - iq2) * l2b);
        float o[8]; float sm = 0.f;
#pragma unroll
        for (int et = 0; et < 8; ++et) { o[et] = aI[et][i] + wq_f * aF[et][i] + wq_b * aB[et][i]; sm += o[et]; }
        sm += __shfl_xor(sm, 1); sm += __shfl_xor(sm, 2); sm += __shfl_xor(sm, 4); sm += __shfl_xor(sm, 8);
        const float mean = sm * (1.0f / 128.0f); float q = 0.f;
#pragma unroll
        for (int et = 0; et < 8; ++et) { o[et] -= mean; q += o[et] * o[et]; }
        q += __shfl_xor(q, 1); q += __shfl_xor(q, 2); q += __shfl_xor(q, 4); q += __shfl_xor(q, 8);
        const float rstd = 1.0f / sqrtf(q * (1.0f / 128.0f) + 1e-5f);
        bf16_t* op = OA + (tok0 + iq2) * 512 + h * 128 + c16;
#pragma unroll
        for (int et = 0; et < 8; ++et) op[et * 16] = bf1(o[et] * rstd * gn[et]);
    }
    __syncthreads();
}
constexpr int NA_LDS_V = 73728, NA_LDS_RPB = 147456, NA_LDS_END = NA_LDS_RPB + 1920;
__device__ __forceinline__ int na_keyk(int row) { return (row & 3) | (((row >> 3) & 1) << 2); }
__device__ __forceinline__ void na_block(int cu, int tid, RLAS unsigned char* lds, bf16_t* OB, const bf16_t* NK, const bf16_t* NVT, const float* rpb) {
    const int rp2 = cu & 127, h = (cu >> 7) & 7, b = cu >> 10; const int lane = tid & 63, w = tid >> 6, g = lane >> 4, c16 = lane & 15;
    const int r0 = 2 * rp2, r = r0 + (w >> 2), g4 = w & 3;
    const int rsA = min(max(r0 - 4, 0), 248), rs = min(max(r - 4, 0), 248), dr = rs - rsA, cb = g4 < 2 ? 0 : 16;
    {
        const bf16_t* Kg = NK + ((size_t)b * L + rsA * 64) * 512 + h * 64; const bf16_t* Vg = NVT + ((size_t)((b * 8 + h) * 64)) * L + rsA * 64;
#pragma unroll 1
        for (int rd = 0; rd < 3; ++rd) {
            bf16x8 kq[3], vq[3];
#pragma unroll
            for (int i = 0; i < 3; ++i) { const int p = tid + 512 * (3 * rd + i); const int row = p >> 3, cc = p & 7; const int e = p / 72, pp = p - e * 72;
                kq[i] = ld8(Kg + (size_t)row * 512 + cc * 8); vq[i] = ld8(Vg + (size_t)e * L + pp * 8); }
#pragma unroll
            for (int i = 0; i < 3; ++i) { const int p = tid + 512 * (3 * rd + i); const int row = p >> 3, cc = p & 7; const int e = p / 72, pp = p - e * 72;
                *(RLAS bf16x8*)(lds + row * 128 + ((cc ^ na_keyk(row)) << 4)) = kq[i];
                *(RLAS bf16x8*)(lds + NA_LDS_V + e * 1152 + ((pp ^ ((e >> 1) & 7)) << 4)) = vq[i]; }
        }
        if (tid < 465) ((RLAS float*)(lds + NA_LDS_RPB))[tid] = rpb[h * 465 + tid];
    }
    const size_t qtok = (size_t)b * L + r * 64 + g4 * 16;
    const bf16_t* Qp = OB + (qtok + c16) * 512 + h * 64 + 8 * g;
    bf16x8 qf[2]; qf[0] = ld8(Qp); qf[1] = ld8(Qp + 32);
    __syncthreads();
    f32x4 S[12][2];
    {
        const int th = c16 >> 3, kkey = (c16 & 3) | (((c16 >> 2) & 1) << 2);
        unsigned kb_[2][2];
#pragma unroll
        for (int tt = 0; tt < 2; ++tt) { const int o = (8 * (c16 >> 2) + 4 * tt + (c16 & 3)) & 15; const int rowl = (dr + 4 * th) * 64 + cb + o;
            kb_[tt][0] = (unsigned)(rowl * 128 + (((0 + g) ^ kkey) << 4)); kb_[tt][1] = (unsigned)(rowl * 128 + (((4 + g) ^ kkey) << 4)); }
#pragma unroll
        for (int kk = 0; kk < 4; ++kk)
#pragma unroll
            for (int ct = 0; ct < 3; ++ct)
#pragma unroll
                for (int tt = 0; tt < 2; ++tt) { const int imm = (kk * 64 + 16 * ct) * 128;
                    f32x4 a = (f32x4){0.f, 0.f, 0.f, 0.f};
                    a = MFMA16(*(const RLAS bf16x8*)(lds + kb_[tt][0] + imm), qf[0], a);
                    a = MFMA16(*(const RLAS bf16x8*)(lds + kb_[tt][1] + imm), qf[1], a); S[3 * kk + ct][tt] = a; }
    }
    const int c = g4 * 16 + c16, cs = min(max(c - 8, 0), 48);
    const RLAS float* rp = (const RLAS float*)(lds + NA_LDS_RPB);
    float mx = -3.0e38f;
    {
        const int krow0 = rs + 4 * (g >> 1) - r + 7, kcl = cb + 8 * (g & 1) - c + 15;
#pragma unroll
        for (int kk = 0; kk < 4; ++kk)
#pragma unroll
            for (int ct = 0; ct < 3; ++ct)
#pragma unroll
                for (int tt = 0; tt < 2; ++tt)
#pragma unroll
                    for (int i = 0; i < 4; ++i) { const int dc = kcl + 16 * ct + 4 * tt + i;
                        const int kc = dc + c - 15; const bool valid = (kc >= cs) && (kc < cs + 16);
                        const int ci = min(max(dc, 0), 30);
                        const float sv = valid ? S[3 * kk + ct][tt][i] + rp[(krow0 + kk) * 31 + ci] : -3.0e38f; S[3 * kk + ct][tt][i] = sv; mx = fmaxf(mx, sv); }
    }
    mx = fmaxf(mx, __shfl_xor(mx, 16)); mx = fmaxf(mx, __shfl_xor(mx, 32));
    float sum = 0.f;
#pragma unroll
    for (int gi = 0; gi < 12; ++gi)
#pragma unroll
        for (int tt = 0; tt < 2; ++tt)
#pragma unroll
            for (int i = 0; i < 4; ++i) { const float pv = __builtin_amdgcn_exp2f((S[gi][tt][i] - mx) * 1.4426950408889634f); S[gi][tt][i] = pv; sum += pv; }
    sum += __shfl_xor(sum, 16); sum += __shfl_xor(sum, 32);
    f32x4 O[4];
#pragma unroll
    for (int et = 0; et < 4; ++et) O[et] = (f32x4){0.f, 0.f, 0.f, 0.f};
    {
        const int vkey = (c16 >> 1) & 7; unsigned vb_[3];
#pragma unroll
        for (int ct = 0; ct < 3; ++ct) { const int low3 = (cb >> 3) + 2 * ct + (g & 1); vb_[ct] = (unsigned)(NA_LDS_V + c16 * 1152 + (((dr + 4 * (g >> 1)) * 8 + (low3 ^ vkey)) << 4)); }
#pragma unroll
        for (int kk = 0; kk < 4; ++kk)
#pragma unroll
            for (int ct = 0; ct < 3; ++ct) { const int gi = 3 * kk + ct;
                const bf16x8 pf = pack8(S[gi][0][0], S[gi][0][1], S[gi][0][2], S[gi][0][3], S[gi][1][0], S[gi][1][1], S[gi][1][2], S[gi][1][3]);
#pragma unroll
                for (int et = 0; et < 4; ++et) O[et] = MFMA16(pf, *(const RLAS bf16x8*)(lds + vb_[ct] + kk * 128 + et * 18432), O[et]); }
    }
    const float rinv = 1.0f / sum;
#pragma unroll
    for (int i = 0; i < 4; ++i) { const float ri = __shfl(rinv, 4 * g + i); bf16_t* op = OB + (qtok + 4 * g + i) * 512 + h * 64 + c16;
#pragma unroll
        for (int et = 0; et < 4; ++et) op[et * 16] = bf1(O[et][i] * ri); }
    __syncthreads();
}
#undef MFMA16
}

namespace cg = cooperative_groups;
#define LAS __attribute__((address_space(3)))
#define GAS __attribute__((address_space(1)))
typedef unsigned short bf16;
typedef unsigned v4u __attribute__((ext_vector_type(4)));
typedef float f32x4 __attribute__((ext_vector_type(4)));
constexpr int NWAVES = 8;
constexpr int BATCH = 2, SEQ = 16384, T = BATCH * SEQ, D = 1024, DEPTH = 2, DIN = 8448, N1 = 3840, N3 = 4608;
constexpr float LN_EPS = 1e-5f;
constexpr size_t SZ_WL = (size_t)(DIN + 1536 + 1024) * 1024 * 2;
constexpr size_t WO_IN = 0, WO_A = (size_t)DIN * 1024, WO_B = WO_A + 1024 * 512, WO_C = WO_B + 1024 * 512, WO_OUT = WO_C + 1024 * 512;
constexpr size_t SZ_H = (size_t)T * 512 * 2;
constexpr size_t WS_W = 0, WS_XB = WS_W + DEPTH * SZ_WL, WS_OA = WS_XB + (size_t)T * D * 2, WS_OB = WS_OA + SZ_H, WS_OC = WS_OB + SZ_H,
                 WS_RK = WS_OC + SZ_H, WS_RKT = WS_RK + SZ_H, WS_RVT = WS_RKT + SZ_H, WS_NK = WS_RVT + SZ_H, WS_NVT = WS_NK + SZ_H,
                 WS_CK = WS_NVT + SZ_H, WS_CV = WS_CK + (size_t)T * 128 * 2, WS_ST = WS_CV + (size_t)T * 128 * 2, WS_END = WS_ST + (size_t)2 * 2 * 4 * 128 * 16384 * 4;
constexpr size_t WS_BAR = WS_END;
constexpr size_t WS_XBAR = 256 + 2 * 128 * 256, WS_ZERO_BYTES = WS_XBAR + 14080, WS_XCH = WS_BAR + WS_ZERO_BYTES;
static_assert(WS_ZERO_BYTES % 256 == 0, "barrier words");
constexpr size_t WS_TOP = WS_XCH + (size_t)32768 * 4 * 8;
constexpr size_t WS_SG = WS_RK, WS_Y = WS_SG + (size_t)T * 3072 * 2;
static_assert(WS_TOP <= (size_t)512 * 1024 * 1024 && WS_END % 256 == 0 && WS_Y + (size_t)T * 1024 * 2 <= WS_END && WS_XB % 256 == 0, "d_ws map");
constexpr int LDS_BYTES = 151552;
static_assert(mix::NA_LDS_END <= LDS_BYTES, "LDS map");

__device__ __forceinline__ int in_src_col(int n) {
    if (n < N1) { const int pn = n >> 8, w = n & 255, bj = w >> 7, wcc = (w >> 5) & 3;
        if (pn < 4) { const int base = (pn < 2) ? 0 : 512, head = 2 * (pn & 1) + (wcc >> 1); return base + head * 128 + bj * 64 + 32 * (wcc & 1); }
        if (pn < 6) return 1024 + 256 * (pn - 4) + w;
        if (pn < 8) return 3072 + 256 * (pn - 6) + w;
        if (pn < 10) return 2048 + 256 * (pn - 8) + w;
        if (pn < 12) return 2560 + 256 * (pn - 10) + w;
        if (pn < 14) { const int head = 4 * (pn - 12) + wcc; return 4096 + head * 64 + bj * 32; }
        if (wcc < 2) return 4608 + wcc * 64 + bj * 32;
        return 4736 + 64 * bj + 32 * (wcc - 2);
    }
    const int c = n - N1;
    if (c < 512) return 1536 + c; if (c < 1024) return 3584 + (c - 512); if (c < 1536) return 4864 + (c - 1024); return 5376 + (c - 1536);
}
__device__ __forceinline__ unsigned f2bf(float f) { unsigned u = __builtin_bit_cast(unsigned, f); return (u + 0x7fffu + ((u >> 16) & 1u)) >> 16; }
__device__ __forceinline__ unsigned pk2(float lo, float hi) { return f2bf(lo) | (f2bf(hi) << 16); }
#define LDS_WAIT() asm volatile("s_waitcnt lgkmcnt(0)" ::: "memory")
__device__ __forceinline__ void transpose_item(const float* W, int K, int N, bf16* WT, bool smap, LAS float* scr, int item, int lane) {
    const int nblk = N / 32, kb = item / nblk, nb = item % nblk, k0 = 64 * kb, n0 = 32 * nb; const int sc0 = smap ? in_src_col(n0) : n0;
#pragma unroll 8
    for (int i = 0; i < 32; ++i) { const int kk = 2 * i + (lane >> 5); scr[kk * 33 + (lane & 31)] = W[(size_t)(k0 + kk) * N + sc0 + (lane & 31)]; }
    LDS_WAIT(); asm volatile("" ::: "memory");
    const int c = lane & 7;
#pragma unroll
    for (int j = 0; j < 4; ++j) { const int n = (lane >> 3) + 8 * j; const LAS float* s = scr + (8 * c) * 33 + n;
        v4u o; o.x = pk2(s[0 * 33], s[1 * 33]); o.y = pk2(s[2 * 33], s[3 * 33]); o.z = pk2(s[4 * 33], s[5 * 33]); o.w = pk2(s[6 * 33], s[7 * 33]);
        *(v4u*)(WT + (size_t)(n0 + n) * K + k0 + 8 * c) = o; }
    LDS_WAIT(); asm volatile("" ::: "memory");
}
__device__ __forceinline__ float wave_sum(float v) {
#pragma unroll
    for (int o = 1; o < 64; o <<= 1) v += __shfl_xor(v, o);
    return v;
}

#define XB_TMO      128
#define XB_XCNT(j)  (256  + 64 * (j))
#define XB_XSUB(j)  (1280 + 64 * (j))
#define XB_XGEN(j)  (2304 + 64 * (j))
#define XB_TOP      3328
#define XB_TOPGEN   3392
#define XCD_BAR_WORDS 3456
#define XB_SPIN_CAP (1u << 18)

__device__ __forceinline__ unsigned xb_ld(unsigned* p)              { return __hip_atomic_load(p, __ATOMIC_RELAXED, __HIP_MEMORY_SCOPE_AGENT); }
__device__ __forceinline__ unsigned xb_add(unsigned* p, unsigned v) { return __hip_atomic_fetch_add(p, v, __ATOMIC_RELAXED, __HIP_MEMORY_SCOPE_AGENT); }
__device__ __forceinline__ unsigned xb_xcc_id() { return (unsigned)__builtin_amdgcn_s_getreg((3 << 11) | 20) & 0xFu; }
#define XB_SPIN(cond, bar) do { unsigned _sp = 0; while (cond) { __builtin_amdgcn_s_sleep(1); \
    if ((++_sp & 255u) == 0u) { if (xb_ld(&(bar)[XB_TMO])) break; if (_sp > XB_SPIN_CAP) { atomicAdd(&(bar)[XB_TMO], 1u); break; } } } } while (0)

struct XcdBarrier {
    unsigned* bar; unsigned x;
    volatile LAS unsigned* st;
};

__device__ __forceinline__ XcdBarrier xcd_barrier_post(unsigned* bar, volatile LAS unsigned* st) {
    XcdBarrier b; b.bar = bar; b.x = xb_xcc_id(); b.st = st;
    if (threadIdx.x == 0) (void)xb_add(&bar[XB_XCNT(b.x)], 1u);
    return b;
}
__device__ __forceinline__ void xcd_barrier_complete(unsigned* bar, unsigned x, unsigned& nloc, unsigned& nx) {
    const unsigned G = gridDim.x * gridDim.y * gridDim.z;
    unsigned sum, cnt, mine, sp = 0u;
    for (;;) {
        sum = 0u; cnt = 0u; mine = 0u;
#pragma unroll
        for (unsigned j = 0; j < 16; ++j) { const unsigned c = xb_ld(&bar[XB_XCNT(j)]); sum += c; cnt += (c > 0u) ? 1u : 0u; mine = (j == x) ? c : mine; }
        if (sum == G) break;
        __builtin_amdgcn_s_sleep(1);
        if ((++sp & 255u) == 0u) { if (xb_ld(&bar[XB_TMO])) break; if (sp > XB_SPIN_CAP) { atomicAdd(&bar[XB_TMO], 1u); break; } }
    }
    nloc = mine > 0u ? mine : 1u; nx = cnt > 0u ? cnt : 1u;
}

__device__ __forceinline__ void xcd_barrier(const XcdBarrier& b) {
    asm volatile("s_waitcnt vmcnt(0)" ::: "memory");
    __syncthreads();
    if (threadIdx.x == 0) {
        unsigned* bar = b.bar;
        __builtin_amdgcn_s_waitcnt(0);
        unsigned nloc = b.st[0], nx = b.st[1];
        if (nloc == 0u) { xcd_barrier_complete(bar, b.x, nloc, nx); b.st[0] = nloc; b.st[1] = nx; }
        const unsigned old = xb_add(&bar[XB_XSUB(b.x)], 1u);
        const unsigned gen = old / nloc;
        if (old + 1u == (gen + 1u) * nloc) {
            __builtin_amdgcn_fence(__ATOMIC_RELEASE, "agent");
            asm volatile("s_waitcnt vmcnt(0)" ::: "memory");
            const unsigned og = xb_add(&bar[XB_TOP], 1u);
            const unsigned tg = og / nx;
            if (og + 1u == (tg + 1u) * nx) xb_add(&bar[XB_TOPGEN], 1u);
            else XB_SPIN(xb_ld(&bar[XB_TOPGEN]) == tg, bar);
            __builtin_amdgcn_fence(__ATOMIC_ACQUIRE, "agent");
            xb_add(&bar[XB_XGEN(b.x)], 1u);
            asm volatile("s_waitcnt vmcnt(0)" ::: "memory");
        } else {
            XB_SPIN(xb_ld(&bar[XB_XGEN(b.x)]) == gen, bar);
            __builtin_amdgcn_fence(__ATOMIC_ACQUIRE, "agent");
            asm volatile("s_waitcnt vmcnt(0)" ::: "memory");
        }
    }
    __syncthreads();
}

struct Args { const float* in[14]; float* out; unsigned char* ws; };
typedef const __attribute__((address_space(4))) unsigned long long* kargp_t;
__device__ __forceinline__ kargp_t kargs() { kargp_t p = (kargp_t)__builtin_amdgcn_kernarg_segment_ptr(); asm volatile("" : "+s"(p)); return p; }
#define ARG_IN(i) ((const float*)(const GAS float*)kargs()[i])
#define ARG_OUT ((float*)(GAS float*)kargs()[14])
#define ARG_WS ((unsigned char*)(GAS unsigned char*)kargs()[15])
#define BF(w, off) ((bf16*)((w) + (off)))
__global__ void __launch_bounds__(NWAVES * 64, 2) fwd(Args args) {
    extern __shared__ __attribute__((aligned(16))) unsigned char lds[];
    cg::grid_group grid = cg::this_grid();
#define PHASE_IDS() int tid = threadIdx.x; asm volatile("" : "+v"(tid)); const int lane = tid & 63, wave = __builtin_amdgcn_readfirstlane(tid >> 6); \
    int G = gridDim.x; asm volatile("" : "+s"(G)); int bx = blockIdx.x; asm volatile("" : "+s"(bx)); \
    const int vcu = (G % 8 == 0) ? (bx % 8) * (G / 8) + bx / 8 : bx; const int gw = vcu * NWAVES + wave, NGW = G * NWAVES; (void)lane; (void)gw; (void)NGW; (void)vcu
    LAS unsigned char* ldsl = (LAS unsigned char*)lds;
    volatile LAS unsigned* xst = (volatile LAS unsigned*)(uintptr_t)151040;
    if (threadIdx.x < 2) xst[threadIdx.x] = 0u;
    __syncthreads();
    { XcdBarrier b0 = xcd_barrier_post((unsigned*)(ARG_WS + WS_BAR + WS_XBAR), xst); (void)b0; }
    grid.sync();
#define GRID_SYNC() do { XcdBarrier xb_; xb_.bar = (unsigned*)(ARG_WS + WS_BAR + WS_XBAR); xb_.x = xb_xcc_id(); xb_.st = xst; xcd_barrier(xb_); } while (0)
    {
        PHASE_IDS(); unsigned char* w = ARG_WS;
        LAS float* scr = (LAS float*)(ldsl + wave * 16384);
        constexpr int I_IN = (1024 / 64) * (DIN / 32), I_BR = (512 / 64) * (1024 / 32), I_OUT = (1024 / 64) * (1024 / 32), I_L = I_IN + 3 * I_BR + I_OUT;
        for (int it = gw; it < DEPTH * I_L; it += NGW) {
            const int l = it / I_L; int r = it % I_L; bf16* WL = BF(w, WS_W + (size_t)l * SZ_WL);
            if (r < I_IN) { transpose_item(ARG_IN(1) + (size_t)l * 1024 * DIN, 1024, DIN, WL + WO_IN, true, scr, r, lane); continue; } r -= I_IN;
            if (r < I_BR) { transpose_item(ARG_IN(8) + (size_t)l * 512 * 1024, 512, 1024, WL + WO_A, false, scr, r, lane); continue; } r -= I_BR;
            if (r < I_BR) { transpose_item(ARG_IN(9) + (size_t)l * 512 * 1024, 512, 1024, WL + WO_B, false, scr, r, lane); continue; } r -= I_BR;
            if (r < I_BR) { transpose_item(ARG_IN(10) + (size_t)l * 512 * 1024, 512, 1024, WL + WO_C, false, scr, r, lane); continue; } r -= I_BR;
            transpose_item(ARG_IN(11) + (size_t)l * 1024 * 1024, 1024, 1024, WL + WO_OUT, false, scr, r, lane);
        }
        const float* x_in = ARG_IN(0); bf16* XB = BF(w, WS_XB);
        for (int m0 = gw; m0 < T; m0 += 4 * NGW) {
            f32x4 v[4][4];
#pragma unroll
            for (int q = 0; q < 4; ++q) { const f32x4* xr = (const f32x4*)(x_in + (size_t)(m0 + q * NGW) * D) + lane;
#pragma unroll
                for (int j = 0; j < 4; ++j) v[q][j] = xr[64 * j]; }
#pragma unroll
            for (int q = 0; q < 4; ++q) { unsigned long long* o8 = (unsigned long long*)(XB + (size_t)(m0 + q * NGW) * D) + lane;
#pragma unroll
                for (int j = 0; j < 4; ++j) o8[64 * j] = (unsigned long long)pk2(v[q][j][0], v[q][j][1]) | ((unsigned long long)pk2(v[q][j][2], v[q][j][3]) << 32); } }
    }
    GRID_SYNC();

#pragma unroll 1
    for (int l = 0; l < DEPTH; ++l) {
        { PHASE_IDS(); unsigned char* w = ARG_WS; const bf16* WL = BF(w, WS_W + (size_t)l * SZ_WL);
          pg8::Gemm g{BF(w, WS_XB), WL + WO_IN, T, N1, D}; pg8::StaticOrder S; S.init(T, N1, G, bx);
          pg8::EpiIn E{BF(w, WS_OA), BF(w, WS_OB), BF(w, WS_OC), BF(w, WS_RK), BF(w, WS_RKT), BF(w, WS_RVT), BF(w, WS_NK), BF(w, WS_NVT), BF(w, WS_CK), BF(w, WS_CV), ARG_IN(6) + l * 64, ARG_IN(7) + l * 64};
          pg8::gemm_phase<pg8::EpiIn, pg8::StaticOrder, true, true>(ldsl, g, S, E);
          }
        GRID_SYNC();
        { PHASE_IDS(); unsigned char* w = ARG_WS; const float* thf = ARG_IN(2) + l * 4; const float* thb = ARG_IN(3) + l * 4;
          for (int cu = vcu; cu < 1024; cu += G) mix::ret_kv_block(cu, tid, ldsl, BF(w, WS_RKT), BF(w, WS_RVT), BF(w, WS_ST), thf, thb);
          }
        GRID_SYNC();
        { PHASE_IDS(); unsigned char* w = ARG_WS; const float* thf = ARG_IN(2) + l * 4; const float* thb = ARG_IN(3) + l * 4; unsigned* ST2 = (unsigned*)(w + WS_ST);
          for (int e = bx * (NWAVES * 64) + tid; e < 16 * 8192; e += G * NWAVES * 64) {
            const int stream = e >> 13, ed2 = e & 8191, dir = stream >> 3, h = stream & 3;
            const float cdec = __builtin_amdgcn_exp2f(128.0f * mix::log2_sigmoid(dir ? thb[h] : thf[h]));
            unsigned* base = ST2 + (size_t)stream * 128 * 8192 + ed2; float s0 = 0.f, s1 = 0.f;
#pragma unroll 1
            for (int nb = 0; nb < 128; nb += 32) {
                unsigned kv[32];
#pragma unroll
                for (int j = 0; j < 32; ++j) { const int n = dir ? 127 - (nb + j) : nb + j; kv[j] = base[(size_t)n * 8192]; }
#pragma unroll
                for (int j = 0; j < 32; ++j) { const int n = dir ? 127 - (nb + j) : nb + j; base[(size_t)n * 8192] = pk2(s0, s1); s0 = cdec * s0 + __uint_as_float(kv[j] << 16); s1 = cdec * s1 + __uint_as_float(kv[j] & 0xffff0000u); }
            }
          } }
        GRID_SYNC();
        { PHASE_IDS(); unsigned char* w = ARG_WS;
          const attn_body::AttnTensors AT{(const attn_body::bf16*)BF(w, WS_OC), (const attn_body::bf16*)BF(w, WS_CK), (const attn_body::bf16*)BF(w, WS_CV), (attn_body::bf16*)BF(w, WS_OC)};
          float gq = fabsf(ARG_IN(6)[l * 64 + lane]), gk = fabsf(ARG_IN(7)[l * 64 + lane]);
#pragma unroll
          for (int o = 1; o < 64; o <<= 1) { gq = fmaxf(gq, __shfl_xor(gq, o)); gk = fmaxf(gk, __shfl_xor(gk, o)); }
          const float Mref = fminf(8.0f * 1.4426950408889634f * gq * gk, 100.0f);
          attn_body::attn_phase<8>((char*)lds, AT, vcu, G, Mref); }
        { PHASE_IDS(); unsigned char* w = ARG_WS; const float* rpb = ARG_IN(5) + l * 8 * 15 * 31;
          for (int cu = vcu; cu < 2048; cu += G) mix::na_block(cu, tid, ldsl, BF(w, WS_OB), BF(w, WS_NK), BF(w, WS_NVT), rpb);
          }
        { PHASE_IDS(); unsigned char* w = ARG_WS; const float* thf = ARG_IN(2) + l * 4; const float* thb = ARG_IN(3) + l * 4; const float* gain = ARG_IN(4) + l * 512;
          for (int cu = vcu; cu < 1024; cu += G) mix::ret_out_block(cu, tid, ldsl, BF(w, WS_OA), BF(w, WS_RK), BF(w, WS_RVT), BF(w, WS_ST), thf, thb, gain);
          }
        GRID_SYNC();
        { PHASE_IDS(); unsigned char* w = ARG_WS; const bf16* WL = BF(w, WS_W + (size_t)l * SZ_WL);
          pg8::Gemm g{BF(w, WS_XB), WL + WO_IN + (size_t)N1 * 1024, T, 1536, D}; pg8::StaticOrder S; S.init(T, 1536, G, bx);
          pg8::EpiZ E{BF(w, WS_OA)};
          pg8::gemm_phase<pg8::EpiZ, pg8::StaticOrder, true, true>(ldsl, g, S, E); }
        { PHASE_IDS(); unsigned char* w = ARG_WS; const bf16* WL = BF(w, WS_W + (size_t)l * SZ_WL);
          pg8::Gemm g{BF(w, WS_XB), WL + WO_IN + (size_t)(N1 + 1536) * 1024, T, 3072, D}; pg8::StaticOrder S; S.init(T, 3072, G, bx);
          pg8::EpiG E{BF(w, WS_SG)};
          pg8::gemm_phase<pg8::EpiG, pg8::StaticOrder, true, true>(ldsl, g, S, E);
          }
        GRID_SYNC();
        {
            PHASE_IDS(); unsigned char* w = ARG_WS; const bf16* WL = BF(w, WS_W + (size_t)l * SZ_WL);
            pg8::Gemm g{BF(w, WS_OA), WL + WO_A, 3 * T, 3 * D, 512}; pg8::BranchOrder S{G, bx};
            pg8::EpiBr E{BF(w, WS_SG), BF(w, WS_Y)};
            pg8::gemm_phase<pg8::EpiBr, pg8::BranchOrder, true, true>(ldsl, g, S, E);
        }
        GRID_SYNC();
        { PHASE_IDS(); unsigned char* w = ARG_WS; const bf16* WL = BF(w, WS_W + (size_t)l * SZ_WL); float* out = ARG_OUT; const float* res = (l == 0) ? ARG_IN(0) : (const float*)out;

          pg8::Gemm g{BF(w, WS_Y), WL + WO_OUT, T, D, D};
          pg8::StaticOrder S; S.init(T, D, G, bx);
          pg8::EpiOutLn E{res, out, BF(w, WS_XB), ARG_IN(12) + l * 1024, ARG_IN(13) + l * 1024, (unsigned long long*)(w + WS_XCH), (unsigned*)(w + WS_BAR) + 64 + l * 128 * 64, 1.4142135623730951f, (l + 1 < DEPTH) ? 1 : 0};
          pg8::gemm_phase<pg8::EpiOutLn, pg8::StaticOrder, true, true>(ldsl, g, S, E); }
        if (l + 1 < DEPTH) GRID_SYNC();
    }
}

extern "C" void kernel_launch(void* const* d_in, const int* in_sizes, int n_in, void* d_out, int out_size, void* d_ws, size_t ws_size, hipStream_t stream) {
    static int grid = 0;
    if (grid == 0) {
        if (n_in != 14 || in_sizes[0] != T * D || out_size != T * D || ws_size < WS_TOP) { fprintf(stderr, "kernel_launch: unexpected shapes (n_in %d, in0 %d, out %d, ws %zu < %zu)\n", n_in, n_in > 0 ? in_sizes[0] : -1, out_size, ws_size, (size_t)WS_END); grid = -1; return; }
        int dev = 0, cus = 0, per_cu = 0;
        hipGetDevice(&dev); hipDeviceGetAttribute(&cus, hipDeviceAttributeMultiprocessorCount, dev);
        if (hipFuncSetAttribute((const void*)fwd, hipFuncAttributeMaxDynamicSharedMemorySize, LDS_BYTES) != hipSuccess) { fprintf(stderr, "kernel_launch: hipFuncSetAttribute failed\n"); grid = -1; return; }
        if (hipOccupancyMaxActiveBlocksPerMultiprocessor(&per_cu, (const void*)fwd, NWAVES * 64, LDS_BYTES) != hipSuccess || per_cu < 1) { fprintf(stderr, "kernel_launch: occupancy query says %d\n", per_cu); per_cu = 1; }
        (void)hipGetLastError();
        grid = cus;
        if (grid != 256) { fprintf(stderr, "kernel_launch: built for 256 CUs (the fused LayerNorm epilogue needs the four column-tile owners of a row panel in the same round); found %d: nothing launched\n", cus); grid = -1; return; }
    }
    if (grid < 0) return;
    if (hipMemsetAsync((char*)d_ws + WS_BAR, 0, WS_ZERO_BYTES, stream) != hipSuccess) { fprintf(stderr, "kernel_launch: hipMemsetAsync failed\n"); return; }
    Args a{};
    for (int i = 0; i < 14; ++i) a.in[i] = (const float*)d_in[i];
    a.out = (float*)d_out; a.ws = (unsigned char*)d_ws;
    void* kargs[] = {&a};
    hipError_t e = hipLaunchCooperativeKernel((const void*)fwd, dim3(grid), dim3(NWAVES * 64), kargs, LDS_BYTES, stream);
    if (e != hipSuccess) fprintf(stderr, "kernel_launch: cooperative launch failed: %s (grid %d)\n", hipGetErrorString(e), grid);
}
```
